# Optimizing an MI355X kernel written in HIP

```python
import jax, jax.numpy as jnp
from jax import lax
import numpy as np

D_MODEL = 1024
BATCH = 8
SEQ = 2048
DEPTH = 1

RW_HEAD = 64
RW_HEADS = 8
RW_WIDTH = RW_HEADS * RW_HEAD
DECAY_LORA = 64
AAA_LORA = 64
GATE_LORA = 128
RW_GN_EPS = 64e-5
RW_COLS = 3 * RW_WIDTH + DECAY_LORA + AAA_LORA + GATE_LORA
RW_SPLITS = [RW_WIDTH, 2 * RW_WIDTH, 3 * RW_WIDTH, 3 * RW_WIDTH + DECAY_LORA, 3 * RW_WIDTH + DECAY_LORA + AAA_LORA]

GLA_HEADS = 4
GLA_DK = 64
GLA_DV = 128
GLA_KW = GLA_HEADS * GLA_DK
GLA_VW = GLA_HEADS * GLA_DV
GLA_GATE_LORA = 16
GLA_TAU = 16.0
GLA_CHUNK = 64
GLA_NORM_EPS = 1e-5
GLA_COLS = 2 * GLA_KW + 2 * GLA_VW + GLA_GATE_LORA
GLA_SPLITS = [GLA_KW, 2 * GLA_KW, 2 * GLA_KW + GLA_VW, 2 * GLA_KW + 2 * GLA_VW]

N_IN = RW_COLS + GLA_COLS + 2 * D_MODEL

D_FF = ((-(-8 * D_MODEL // 3)) + 255) // 256 * 256

ALPHA = (2.0 * DEPTH) ** 0.25
BETA = (8.0 * DEPTH) ** -0.25
LN_EPS = 1e-5

kernel_name = "hybrid_rwkv7_gla_deepnorm_adaln_block"


def _layer_norm(x, eps):
    x32 = x.astype(jnp.float32)
    mu = jnp.mean(x32, -1, keepdims=True)
    var = jnp.mean(jnp.square(x32 - mu), -1, keepdims=True)
    return (x32 - mu) * lax.rsqrt(var + eps)


def _token_shift(p, mu):
    p_prev = jnp.pad(p, ((0, 0), (1, 0), (0, 0)))[:, :-1, :]
    return p + mu * (p_prev - p)


def _rwkv7_branch(p, mu, w0, w2, a0, a2, g2, k_k, k_a, r_k, gn_g, gn_b):
    B, T, _ = p.shape
    H, N = RW_HEADS, RW_HEAD
    f32 = jnp.float32
    p = _token_shift(p, mu)
    r, k, v, wd, ad, gd = jnp.split(p, RW_SPLITS, axis=-1)
    w = -jax.nn.softplus(-(w0 + jnp.tanh(wd) @ w2).astype(f32)) - 0.5
    decay = jnp.exp(-jnp.exp(w))
    a = jax.nn.sigmoid((a0 + ad @ a2).astype(f32))
    g = jax.nn.sigmoid(gd) @ g2
    kk = (k * k_k).astype(f32).reshape(B, T, H, N)
    kk = kk / jnp.maximum(jnp.sqrt(jnp.sum(kk * kk, -1, keepdims=True)), 1e-12)
    k = k.astype(f32) * (1.0 + (a - 1.0) * k_a.astype(f32))
    heads = lambda t: t.astype(f32).reshape(B, T, H, N)
    rh, kh, vh, wh, ah = heads(r), heads(k), heads(v), heads(decay), heads(a)
    bh = kk * ah

    def step(S, inp):
        r_t, w_t, k_t, v_t, kk_t, b_t = inp
        sa = jnp.einsum('bhvk,bhk->bhv', S, -kk_t)
        S = S * w_t[:, :, None, :] + sa[..., None] * b_t[:, :, None, :] + v_t[..., None] * k_t[:, :, None, :]
        return S, jnp.einsum('bhvk,bhk->bhv', S, r_t)

    xs = tuple(jnp.swapaxes(t, 0, 1) for t in (rh, wh, kh, vh, kk, bh))
    _, y = lax.scan(step, jnp.zeros((B, H, N, N), f32), xs)
    y = jnp.swapaxes(y, 0, 1)
    y = _layer_norm(y, RW_GN_EPS).reshape(B, T, RW_WIDTH) * gn_g.astype(f32) + gn_b.astype(f32)
    bonus = jnp.sum(rh * kh * r_k.astype(f32), -1, keepdims=True) * vh
    out = (y + bonus.reshape(B, T, RW_WIDTH)) * g.astype(f32)
    return out.astype(p.dtype)


def _gla_branch(p, a2, a_b, norm_g):
    B, T, _ = p.shape
    H, DK, DV, C = GLA_HEADS, GLA_DK, GLA_DV, GLA_CHUNK
    NC = T // C
    f32 = jnp.float32
    q, k, v, gg, ad = jnp.split(p, GLA_SPLITS, axis=-1)
    log_a = jax.nn.log_sigmoid((ad @ a2 + a_b).astype(f32)) / GLA_TAU

    def chunks(t, d):
        return t.astype(f32).reshape(B, NC, C, H, d).transpose(0, 3, 1, 2, 4)

    qc = chunks(q, DK) * (DK ** -0.5)
    kc, vc, lc = chunks(k, DK), chunks(v, DV), chunks(log_a, DK)
    b = jnp.cumsum(lc, axis=3)
    q_s = qc * jnp.exp(b)
    k_s = kc * jnp.exp(-b)
    causal = jnp.tril(jnp.ones((C, C), dtype=bool))
    att = jnp.where(causal, jnp.einsum('bhncd,bhnsd->bhncs', q_s, k_s), 0.0)
    o_intra = jnp.einsum('bhncs,bhnsv->bhncv', att, vc)
    b_last = b[:, :, :, -1:, :]
    chunk_kv = jnp.einsum('bhncd,bhncv->bhndv', kc * jnp.exp(b_last - b), vc)
    chunk_decay = jnp.exp(b_last[:, :, :, 0, :])

    def step(S, inp):
        dec, kv = inp
        return dec[..., None] * S + kv, S

    _, S_prev = lax.scan(step, jnp.zeros((B, H, DK, DV), f32),
                         (jnp.moveaxis(chunk_decay, 2, 0), jnp.moveaxis(chunk_kv, 2, 0)))
    S_prev = jnp.moveaxis(S_prev, 0, 2)
    o = o_intra + jnp.einsum('bhncd,bhndv->bhncv', q_s, S_prev)
    o = o.transpose(0, 2, 3, 1, 4).reshape(B, T, H, DV)
    o = o * lax.rsqrt(jnp.mean(o * o, -1, keepdims=True) + GLA_NORM_EPS) * norm_g.astype(f32)
    o = o.reshape(B, T, GLA_VW) * jax.nn.silu(gg.astype(f32))
    return o.astype(p.dtype)


def setup_inputs(seed: int = 0) -> dict:
    key = jax.random.key(seed)
    ks = jax.random.split(key, 32)
    L, D = DEPTH, D_MODEL
    nrm = lambda k, shape, s: jax.random.normal(k, shape, jnp.float32) * s
    rw_w0 = jnp.broadcast_to(jnp.linspace(-6.0, -1.0, RW_WIDTH, dtype=jnp.float32), (L, RW_WIDTH)) + nrm(ks[6], (L, RW_WIDTH), 0.1)
    return {
        "x": nrm(ks[0], (BATCH, SEQ, D), 1.0),
        "c": nrm(ks[1], (BATCH, D), 1.0),
        "w_ada": nrm(ks[2], (L, D, 6 * D), 0.5 * D ** -0.5),
        "b_ada": nrm(ks[3], (L, 6 * D), 0.02),
        "w_in": nrm(ks[4], (L, D, N_IN), D ** -0.5),
        "mu_rw": jax.random.uniform(ks[5], (L, RW_COLS), jnp.float32),
        "rw_w0": rw_w0,
        "rw_w2": nrm(ks[7], (L, DECAY_LORA, RW_WIDTH), 0.1 * DECAY_LORA ** -0.5),
        "rw_a0": nrm(ks[8], (L, RW_WIDTH), 0.1),
        "rw_a2": nrm(ks[9], (L, AAA_LORA, RW_WIDTH), 0.5 * AAA_LORA ** -0.5),
        "rw_g2": nrm(ks[10], (L, GATE_LORA, RW_WIDTH), GATE_LORA ** -0.5),
        "rw_k_k": 0.85 + nrm(ks[11], (L, RW_WIDTH), 0.02),
        "rw_k_a": 1.0 + nrm(ks[12], (L, RW_WIDTH), 0.02),
        "rw_r_k": nrm(ks[13], (L, RW_HEADS, RW_HEAD), 0.1),
        "rw_gn_g": 1.0 + nrm(ks[14], (L, RW_WIDTH), 0.05),
        "rw_gn_b": nrm(ks[15], (L, RW_WIDTH), 0.02),
        "gla_a2": nrm(ks[16], (L, GLA_GATE_LORA, GLA_KW), GLA_GATE_LORA ** -0.5),
        "gla_a_b": nrm(ks[17], (L, GLA_KW), 0.1),
        "gla_norm_g": 1.0 + nrm(ks[18], (L, GLA_DV), 0.05),
        "w_rw_branch": nrm(ks[19], (L, RW_WIDTH, D), BETA * RW_WIDTH ** -0.5),
        "w_gla_branch": nrm(ks[20], (L, GLA_VW, D), BETA * GLA_VW ** -0.5),
        "w_mix_out": nrm(ks[21], (L, D, D), BETA * D ** -0.5),
        "ln1_g": 1.0 + nrm(ks[22], (L, D), 0.05),
        "ln1_b": nrm(ks[23], (L, D), 0.02),
        "w_ffn_in": nrm(ks[24], (L, D, 2 * D_FF), D ** -0.5),
        "w_ffn_out": nrm(ks[25], (L, D_FF, D), BETA * D_FF ** -0.5),
        "ln2_g": 1.0 + nrm(ks[26], (L, D), 0.05),
        "ln2_b": nrm(ks[27], (L, D), 0.02),
    }


def reference(x, c, w_ada, b_ada, w_in, mu_rw, rw_w0, rw_w2, rw_a0, rw_a2, rw_g2, rw_k_k, rw_k_a,
              rw_r_k, rw_gn_g, rw_gn_b, gla_a2, gla_a_b, gla_norm_g, w_rw_branch, w_gla_branch,
              w_mix_out, ln1_g, ln1_b, w_ffn_in, w_ffn_out, ln2_g, ln2_b):
    for l in range(DEPTH):
        mod = (jax.nn.silu(c) @ w_ada[l] + b_ada[l])[:, None, :]
        shift1, scale1, gate1, shift2, scale2, gate2 = jnp.split(mod, 6, axis=-1)

        u = x * (1.0 + scale1) + shift1
        proj = u @ w_in[l]
        p_rw, p_gla, p_gate = jnp.split(proj, [RW_COLS, RW_COLS + GLA_COLS], axis=-1)
        gate_rw, gate_gla = jnp.split(p_gate, 2, axis=-1)
        o_rw = _rwkv7_branch(p_rw, mu_rw[l], rw_w0[l], rw_w2[l], rw_a0[l], rw_a2[l], rw_g2[l],
                             rw_k_k[l], rw_k_a[l], rw_r_k[l], rw_gn_g[l], rw_gn_b[l])
        o_gla = _gla_branch(p_gla, gla_a2[l], gla_a_b[l], gla_norm_g[l])
        merged = (jax.nn.sigmoid(gate_rw) * (o_rw @ w_rw_branch[l])
                  + jax.nn.sigmoid(gate_gla) * (o_gla @ w_gla_branch[l]))
        mix = merged @ w_mix_out[l]
        x = (_layer_norm(ALPHA * x + gate1 * mix, LN_EPS) * ln1_g[l] + ln1_b[l]).astype(x.dtype)

        u2 = x * (1.0 + scale2) + shift2
        h_gate, h_up = jnp.split(u2 @ w_ffn_in[l], 2, axis=-1)
        ffn = (jax.nn.silu(h_gate) * h_up) @ w_ffn_out[l]
        x = (_layer_norm(ALPHA * x + gate2 * ffn, LN_EPS) * ln2_g[l] + ln2_b[l]).astype(x.dtype)
    return x
```

```cpp
#include <hip/hip_runtime.h>
#include <hip/hip_cooperative_groups.h>
#include <cstdio>
#include <cstdint>
namespace cg = cooperative_groups;
namespace pg8 {
#define PG8_LAS __attribute__((address_space(3)))
typedef unsigned short bf16_t;
typedef short bf16x8 __attribute__((ext_vector_type(8)));
typedef float f32x4 __attribute__((ext_vector_type(4)));
typedef unsigned u32x4 __attribute__((ext_vector_type(4)));
constexpr int BM = 256, BK = 64, HALF = 128, HTB = HALF * BK * 2  , STAGE_BYTES = 8 * HTB, NXCD = 8, WGM = 8;

__host__ __device__ __forceinline__ int lds_byte(int r, int c) { const int st = (r >> 4) * 2 + (c >> 5), rr = r & 15, cc = c & 31, ob = rr * 64 + cc * 2; return st * 1024 + (ob ^ (((ob >> 9) & 1) << 5)); }
__host__ __device__ __forceinline__ void stage_rc(int b, int& R, int& C) { const int st = b / 1024, sb = b % 1024, swz = sb ^ (((sb >> 9) & 1) << 5); R = (st >> 1) * 16 + swz / 64; C = (st & 1) * 32 + (swz % 64) / 2; }
__host__ __device__ __forceinline__ int perm32(int rho) { const int n = rho >> 4, i = rho & 15; return 8 * (i >> 2) + 4 * n + (i & 3); }

struct Unit { int pm, pn; };
struct Gemm { const bf16_t* A; const bf16_t* Bt; int M, N, K; const bf16_t* A2; int nsplit; };

struct StaticOrder {
    int nM, nN, nwg, G, c;
    __host__ __device__ void init(int M, int N, int G_, int c_) { nM = M / BM; nN = N / BM; nwg = nM * nN; G = G_; c = c_; }
    __host__ __device__ bool next(int i, Unit& u) const {
        const long L = (long)i * G + c; if (L >= nwg) return false;
        int wgid = (int)L; { const int q = nwg / NXCD, r = nwg % NXCD, xcd = wgid % NXCD, off = wgid / NXCD; wgid = (xcd < r ? xcd * (q + 1) : r * (q + 1) + (xcd - r) * q) + off; }
        const int nig = WGM * nN, gid = wgid / nig, fm = gid * WGM, gsz = (nM - fm) < WGM ? (nM - fm) : WGM;
        u.pm = fm + ((wgid % nig) % gsz); u.pn = (wgid % nig) / gsz; return true;
    }
    __device__ __forceinline__ void a_ready(const Unit&) const {}
    __device__ __forceinline__ void done(const Unit&) const {}
};

__device__ __forceinline__ unsigned cvt_pk_bf16(float lo, float hi) { unsigned r; asm volatile("v_cvt_pk_bf16_f32 %0, %1, %2" : "=v"(r) : "v"(lo), "v"(hi)); return r; }
typedef float f32x2 __attribute__((ext_vector_type(2)));
template <class Epi, class Sched, bool ALIGN_EPI = false, bool SP2 = false>
__device__ __forceinline__ void gemm_phase(PG8_LAS unsigned char* lds, const Gemm g, const Sched& S, const Epi& E) {
    const int tid = threadIdx.x, wid = __builtin_amdgcn_readfirstlane(tid >> 6), lane = tid & 63, wr = wid >> 2, wc = wid & 3, fr = lane & 15, fq = lane >> 4;
    const int K = g.K, nt = K / BK;
    unsigned voffA[2], voffB[2];
#pragma unroll
    for (int i = 0; i < 2; ++i) { int R, C; stage_rc(tid * 16 + i * 8192, R, C); const int Rb = Epi::PERM ? ((R & ~31) + perm32(R & 31)) : R;
        voffA[i] = (unsigned)(R * K + C) * 2u; voffB[i] = (unsigned)(Rb * K + C) * 2u; }
    const size_t kstep = (size_t)(BK * 2);
    const size_t hstep = (size_t)HALF * K * 2;
    const size_t tstep = 2 * hstep;
    const unsigned ldsw = (unsigned)wid * 1024u;
    const int aoff = lds_byte(wr * 64 + fr, fq * 8), boff = lds_byte(wc * 32 + fr, fq * 8);
#define PG8_SA(b, h) (((b) * 2 + (h)) * HTB)
#define PG8_SB(b, h) ((4 + (b) * 2 + (h)) * HTB)
#define PG8_STAGE(bufoff, gbase, voff) do { _Pragma("unroll") for (int _i = 0; _i < 2; ++_i) \
        __builtin_amdgcn_global_load_lds((const unsigned*)((const char*)(gbase) + (voff)[_i]), (PG8_LAS unsigned*)(lds + (bufoff) + ldsw + _i * 8192), 16, 0, 0); } while (0)
#define PG8_LDA(dst, b, h) do { _Pragma("unroll") for (int m = 0; m < 4; ++m) _Pragma("unroll") for (int k = 0; k < 2; ++k) dst[m][k] = *(const PG8_LAS bf16x8*)(lds + PG8_SA(b, h) + aoff + m * 2048 + k * 1024); } while (0)
#define PG8_LDB(dst, b, h) do { _Pragma("unroll") for (int n = 0; n < 2; ++n) _Pragma("unroll") for (int k = 0; k < 2; ++k) dst[n][k] = *(const PG8_LAS bf16x8*)(lds + PG8_SB(b, h) + boff + n * 2048 + k * 1024); } while (0)
#define PG8_MMA(ai, bj, At, Bt) do { __builtin_amdgcn_s_setprio(1); _Pragma("unroll") for (int m = 0; m < 4; ++m) _Pragma("unroll") for (int n = 0; n < 2; ++n) _Pragma("unroll") for (int k = 0; k < 2; ++k) \
        acc[ai][bj][m][n] = __builtin_amdgcn_mfma_f32_16x16x32_bf16(Bt[n][k], At[m][k], acc[ai][bj][m][n], 0, 0, 0); __builtin_amdgcn_s_setprio(0); } while (0)
#define PG8_WAIT_V(n) asm volatile("s_waitcnt vmcnt(" #n ")" ::: "memory")
#define PG8_WAIT_L(n) asm volatile("s_waitcnt lgkmcnt(" #n ")" ::: "memory")
#define PG8_BAR __builtin_amdgcn_s_barrier()
#define PG8_SCHED __builtin_amdgcn_sched_barrier(0)
    Unit cur, nxt; int ui = 0;
    if (!S.next(0, cur)) return;
    f32x4 acc[2][2][4][2];
#pragma unroll
    for (int a = 0; a < 2; ++a)
#pragma unroll
        for (int b = 0; b < 2; ++b)
#pragma unroll
            for (int m = 0; m < 4; ++m)
#pragma unroll
                for (int n = 0; n < 2; ++n) acc[a][b][m][n] = (f32x4){0.f, 0.f, 0.f, 0.f};
    bf16x8 At[4][2], B0[2][2], B1[2][2];
    const char* cA = (const char*)(cur.pn >= g.nsplit ? g.A2 : g.A) + (size_t)cur.pm * tstep; const char* cB = (const char*)g.Bt + (size_t)cur.pn * tstep;
    S.a_ready(cur);
    if constexpr (SP2) {
        PG8_STAGE(PG8_SB(0, 0), cB, voffB); PG8_STAGE(PG8_SB(0, 1), cB + hstep, voffB); PG8_STAGE(PG8_SA(0, 0), cA, voffA); PG8_STAGE(PG8_SA(0, 1), cA + hstep, voffA);
        if (wr == 1) PG8_BAR;
        PG8_WAIT_V(2); PG8_BAR;
        PG8_STAGE(PG8_SB(1, 0), cB + kstep, voffB); PG8_STAGE(PG8_SA(1, 0), cA + kstep, voffA); PG8_STAGE(PG8_SB(1, 1), cB + hstep + kstep, voffB);
        PG8_WAIT_V(6); PG8_BAR;
    } else {
        PG8_STAGE(PG8_SB(0, 0), cB, voffB); PG8_STAGE(PG8_SA(0, 0), cA, voffA); PG8_STAGE(PG8_SB(0, 1), cB + hstep, voffB); PG8_STAGE(PG8_SA(0, 1), cA + hstep, voffA);
        if (wr == 1) PG8_BAR;
        PG8_WAIT_V(4); PG8_BAR;
        PG8_STAGE(PG8_SB(1, 0), cB + kstep, voffB); PG8_STAGE(PG8_SA(1, 0), cA + kstep, voffA); PG8_STAGE(PG8_SB(1, 1), cB + hstep + kstep, voffB);
        PG8_WAIT_V(6); PG8_BAR;
    }
    for (;;) {
        const bool has_next = S.next(ui + 1, nxt);
        const char* nA = has_next ? (const char*)(nxt.pn >= g.nsplit ? g.A2 : g.A) + (size_t)nxt.pm * tstep : cA; const char* nB = has_next ? (const char*)g.Bt + (size_t)nxt.pn * tstep : cB;
        for (int t = 0; t < nt; t += 2) {
            const bool last = (t == nt - 2);
            const char* a1 = cA + (size_t)(t + 1) * kstep;
            const char* a2 = last ? nA : cA + (size_t)(t + 2) * kstep; const char* b2 = last ? nB : cB + (size_t)(t + 2) * kstep;
            const char* a3 = a2 + kstep; const char* b3 = b2 + kstep;
            if (last && has_next) S.a_ready(nxt);
            if constexpr (SP2) {
            PG8_LDB(B0, 0, 0); PG8_LDB(B1, 0, 1); PG8_SCHED; PG8_LDA(At, 0, 0); PG8_STAGE(PG8_SA(1, 1), a1 + hstep, voffA);
            PG8_WAIT_V(8); PG8_WAIT_L(0); PG8_BAR; PG8_MMA(0, 0, At, B0); PG8_MMA(0, 1, At, B1); PG8_BAR; PG8_SCHED;
            PG8_LDA(At, 0, 1); PG8_STAGE(PG8_SB(0, 0), b2, voffB); PG8_STAGE(PG8_SB(0, 1), b2 + hstep, voffB); PG8_STAGE(PG8_SA(0, 0), a2, voffA);
            PG8_WAIT_V(8); PG8_WAIT_L(0); PG8_BAR; PG8_MMA(1, 0, At, B0); PG8_MMA(1, 1, At, B1); PG8_BAR; PG8_SCHED;
            PG8_LDB(B0, 1, 0); PG8_LDB(B1, 1, 1); PG8_SCHED; PG8_LDA(At, 1, 0); PG8_STAGE(PG8_SA(0, 1), a2 + hstep, voffA);
            PG8_WAIT_V(8); PG8_WAIT_L(0); PG8_BAR; PG8_MMA(0, 0, At, B0); PG8_MMA(0, 1, At, B1); PG8_BAR; PG8_SCHED;
            PG8_LDA(At, 1, 1); PG8_STAGE(PG8_SB(1, 0), b3, voffB); PG8_STAGE(PG8_SB(1, 1), b3 + hstep, voffB); PG8_STAGE(PG8_SA(1, 0), a3, voffA);
            PG8_WAIT_V(8); PG8_WAIT_L(0); PG8_BAR; PG8_MMA(1, 0, At, B0); PG8_MMA(1, 1, At, B1); PG8_BAR; PG8_SCHED;
            } else {
            PG8_LDB(B0, 0, 0); PG8_SCHED; PG8_LDA(At, 0, 0); PG8_STAGE(PG8_SA(1, 1), a1 + hstep, voffA);
            PG8_WAIT_L(8); PG8_BAR; PG8_WAIT_L(0); PG8_MMA(0, 0, At, B0); PG8_BAR; PG8_SCHED;
            PG8_LDB(B1, 0, 1); PG8_STAGE(PG8_SB(0, 0), b2, voffB);
            PG8_BAR; PG8_WAIT_L(0); PG8_MMA(0, 1, At, B1); PG8_BAR;
            PG8_LDA(At, 0, 1); PG8_STAGE(PG8_SA(0, 0), a2, voffA);
            PG8_BAR; PG8_WAIT_L(0); PG8_MMA(1, 0, At, B0); PG8_BAR; PG8_SCHED;
            PG8_STAGE(PG8_SB(0, 1), b2 + hstep, voffB);
            PG8_WAIT_V(6); PG8_BAR; PG8_MMA(1, 1, At, B1); PG8_BAR;
            PG8_LDB(B0, 1, 0); PG8_SCHED; PG8_LDA(At, 1, 0); PG8_STAGE(PG8_SA(0, 1), a2 + hstep, voffA);
            PG8_WAIT_L(8); PG8_BAR; PG8_WAIT_L(0); PG8_MMA(0, 0, At, B0); PG8_BAR; PG8_SCHED;
            PG8_LDB(B1, 1, 1); PG8_STAGE(PG8_SB(1, 0), b3, voffB);
            PG8_BAR; PG8_WAIT_L(0); PG8_MMA(0, 1, At, B1); PG8_BAR;
            PG8_LDA(At, 1, 1); PG8_STAGE(PG8_SA(1, 0), a3, voffA);
            PG8_BAR; PG8_WAIT_L(0); PG8_MMA(1, 0, At, B0); PG8_BAR; PG8_SCHED;
            PG8_STAGE(PG8_SB(1, 1), b3 + hstep, voffB);
            PG8_WAIT_V(6); PG8_BAR; PG8_MMA(1, 1, At, B1); PG8_BAR;
            }
        }
        if constexpr (ALIGN_EPI) { if (wr == 0) PG8_BAR; }
        if constexpr (!Epi::AFTER_DRAIN) { E(acc, cur, wr, wc, fr, fq); S.done(cur); }
        if (!has_next) break;
#pragma unroll
        for (int a = 0; a < 2; ++a)
#pragma unroll
            for (int b = 0; b < 2; ++b)
#pragma unroll
                for (int m = 0; m < 4; ++m)
#pragma unroll
                    for (int n = 0; n < 2; ++n) acc[a][b][m][n] = (f32x4){0.f, 0.f, 0.f, 0.f};
        cur = nxt; cA = nA; cB = nB; ++ui;
        if constexpr (ALIGN_EPI) { if (wr == 1) PG8_BAR; }
    }
    PG8_WAIT_V(0);
    if constexpr (!ALIGN_EPI) { if (wr == 0) PG8_BAR; }
    PG8_BAR;
    if constexpr (Epi::AFTER_DRAIN) { E.fused(acc, cur, wr, wc, fr, fq, lds, wid, lane); S.done(cur); }
#undef PG8_SA
#undef PG8_SB
#undef PG8_STAGE
#undef PG8_LDA
#undef PG8_LDB
#undef PG8_MMA
#undef PG8_WAIT_V
#undef PG8_WAIT_L
#undef PG8_BAR
#undef PG8_SCHED
}
}

#define LAS __attribute__((address_space(3)))
typedef unsigned short bf16;
typedef float f4 __attribute__((ext_vector_type(4)));
typedef float f2 __attribute__((ext_vector_type(2)));
typedef unsigned u4 __attribute__((ext_vector_type(4)));
typedef unsigned u2 __attribute__((ext_vector_type(2)));

constexpr int NT = 512, NWAVE = 8;
constexpr int D = 1024, NBATCH = 8, SEQ = 2048, M = NBATCH * SEQ;
constexpr int RWC = 1792, GLCP = 1792, NGATE = 2048, NPROJ = 5632, NIN = 5392, DFF = 2816;
constexpr float ALPHA = 1.189207115002721f, LN_EPS = 1e-5f, GN_EPS = 64e-5f, GLA_EPS = 1e-5f;
constexpr int LDS_BYTES = 147456;

constexpr size_t MiB = 1u << 20;
constexpr size_t WS_MOD = 0, WS_SB = 1 * MiB, WS_WIN = 2 * MiB, WS_W1 = 13 * MiB, WS_W2 = 24 * MiB, WS_WBR = 30 * MiB, WS_WMIX = 32 * MiB,
                 WS_U = 36 * MiB, WS_RWP = 68 * MiB, WS_GLAP = 124 * MiB, WS_GATES = 180 * MiB, WS_MG = 68 * MiB, WS_H = 68 * MiB;

__device__ __forceinline__ unsigned f2bf(float f) { unsigned u = __builtin_bit_cast(unsigned, f); return (u + 0x7fffu + ((u >> 16) & 1u)) >> 16; }
__device__ __forceinline__ unsigned pk2(float lo, float hi) { return f2bf(lo) | (f2bf(hi) << 16); }
__device__ __forceinline__ float bf2f(unsigned short b) { return __builtin_bit_cast(float, ((unsigned)b) << 16); }
__device__ __forceinline__ float bflo(unsigned w) { return __builtin_bit_cast(float, w << 16); }
__device__ __forceinline__ float bfhi(unsigned w) { return __builtin_bit_cast(float, w & 0xffff0000u); }
__device__ __forceinline__ float sigm(float x) { return 1.f / (1.f + __expf(-x)); }
__device__ __forceinline__ float wave_sum(float v) {
#pragma unroll
    for (int o = 1; o < 64; o <<= 1) v += __shfl_xor(v, o);
    return v;
}
template <int CTRL> __device__ __forceinline__ float dppf(float x) { return __builtin_bit_cast(float, __builtin_amdgcn_mov_dpp(__builtin_bit_cast(int, x), CTRL, 0xf, 0xf, true)); }
__device__ __forceinline__ float reduce16(float x) { x += dppf<0xB1>(x); x += dppf<0x4E>(x); x += dppf<0x141>(x); x += dppf<0x128>(x); return x; }
#define LDS_WAIT() asm volatile("s_waitcnt lgkmcnt(0)" ::: "memory")

struct Args { const float* in[28]; float* out; unsigned char* ws; };

struct EpiProj {
    static constexpr bool PERM = true, AFTER_DRAIN = false;
    bf16 *RWP, *GLAP, *GATES;
    __device__ __forceinline__ void operator()(const pg8::f32x4 (&acc)[2][2][4][2], const pg8::Unit& u, int wr, int wc, int fr, int fq) const {
        bf16* base; int ldc, colt; bool sg;
        if (u.pn < 7) { base = RWP; ldc = RWC; colt = u.pn * 256; sg = false; }
        else if (u.pn < 14) { base = GLAP; ldc = GLCP; colt = (u.pn - 7) * 256; sg = false; }
        else { base = GATES; ldc = NGATE; colt = (u.pn - 14) * 256; sg = true; }
        const int row0 = u.pm * 256 + wr * 64 + fr, col0 = colt + wc * 32 + 8 * fq;
#pragma unroll
        for (int ai = 0; ai < 2; ++ai)
#pragma unroll
            for (int m = 0; m < 4; ++m) { bf16* rowp = base + (size_t)(row0 + ai * 128 + m * 16) * ldc + col0;
#pragma unroll
                for (int bj = 0; bj < 2; ++bj) { pg8::f32x4 v0 = acc[ai][bj][m][0], v1 = acc[ai][bj][m][1];
                    if (sg) {
#pragma unroll
                        for (int j = 0; j < 4; ++j) { v0[j] = sigm(v0[j]); v1[j] = sigm(v1[j]); } }
                    u4 w; w.x = pk2(v0[0], v0[1]); w.y = pk2(v0[2], v0[3]); w.z = pk2(v1[0], v1[1]); w.w = pk2(v1[2], v1[3]);
                    *(u4*)(rowp + bj * 128) = w; } }
    }
};
struct EpiGate {
    static constexpr bool PERM = true, AFTER_DRAIN = false;
    bf16* MG; const bf16* GATES;
    __device__ __forceinline__ void operator()(const pg8::f32x4 (&acc)[2][2][4][2], const pg8::Unit& u, int wr, int wc, int fr, int fq) const {
        const int row0 = u.pm * 256 + wr * 64 + fr, col0 = u.pn * 256 + wc * 32 + 8 * fq;
#pragma unroll
        for (int ai = 0; ai < 2; ++ai)
#pragma unroll
            for (int m = 0; m < 4; ++m) { const size_t off = (size_t)(row0 + ai * 128 + m * 16) * NGATE + col0;
#pragma unroll
                for (int bj = 0; bj < 2; ++bj) { const pg8::f32x4 v0 = acc[ai][bj][m][0], v1 = acc[ai][bj][m][1];
                    const u4 gt = *(const u4*)(GATES + off + bj * 128);
                    u4 w; w.x = pk2(v0[0] * bflo(gt.x), v0[1] * bfhi(gt.x)); w.y = pk2(v0[2] * bflo(gt.y), v0[3] * bfhi(gt.y));
                    w.z = pk2(v1[0] * bflo(gt.z), v1[1] * bfhi(gt.z)); w.w = pk2(v1[2] * bflo(gt.w), v1[3] * bfhi(gt.w));
                    *(u4*)(MG + off + bj * 128) = w; } }
    }
};
struct EpiRes {
    static constexpr bool PERM = false, AFTER_DRAIN = false;
    const float* base; float* out; const float* gate;
    __device__ __forceinline__ void operator()(const pg8::f32x4 (&acc)[2][2][4][2], const pg8::Unit& u, int wr, int wc, int fr, int fq) const {
        const int row0 = u.pm * 256 + wr * 64 + fr, col0 = u.pn * 256 + wc * 32 + 4 * fq;
        const float* gp = gate + (size_t)(u.pm >> 3) * 6144 + col0;
        pg8::f32x4 gv[2][2];
#pragma unroll
        for (int bj = 0; bj < 2; ++bj)
#pragma unroll
            for (int n = 0; n < 2; ++n) gv[bj][n] = *(const pg8::f32x4*)(gp + bj * 128 + n * 16);
#pragma unroll
        for (int ai = 0; ai < 2; ++ai)
#pragma unroll
            for (int m = 0; m < 4; ++m) { const size_t off = (size_t)(row0 + ai * 128 + m * 16) * D + col0;
#pragma unroll
                for (int bj = 0; bj < 2; ++bj)
#pragma unroll
                    for (int n = 0; n < 2; ++n) { const pg8::f32x4 bs = *(const pg8::f32x4*)(base + off + bj * 128 + n * 16);
                        *(pg8::f32x4*)(out + off + bj * 128 + n * 16) = bs * ALPHA + gv[bj][n] * acc[ai][bj][m][n]; } }
    }
};
struct EpiSwiGLU {
    static constexpr bool PERM = true, AFTER_DRAIN = false;
    bf16* H;
    __device__ __forceinline__ void operator()(const pg8::f32x4 (&acc)[2][2][4][2], const pg8::Unit& u, int wr, int wc, int fr, int fq) const {
        const int row0 = u.pm * 256 + wr * 64 + fr, col0 = u.pn * 128 + wc * 32 + 8 * fq;
#pragma unroll
        for (int ai = 0; ai < 2; ++ai)
#pragma unroll
            for (int m = 0; m < 4; ++m) { bf16* rowp = H + (size_t)(row0 + ai * 128 + m * 16) * DFF + col0;
                float h[8];
#pragma unroll
                for (int n = 0; n < 2; ++n)
#pragma unroll
                    for (int j = 0; j < 4; ++j) { const float g = acc[ai][0][m][n][j], up = acc[ai][1][m][n][j]; h[n * 4 + j] = g * sigm(g) * up; }
                u4 w; w.x = pk2(h[0], h[1]); w.y = pk2(h[2], h[3]); w.z = pk2(h[4], h[5]); w.w = pk2(h[6], h[7]);
                *(u4*)rowp = w; }
    }
};

__device__ __forceinline__ void p0_mod(const float* c, const float* w_ada, const float* b_ada, float* MOD, LAS float* ldsf) {
    const int tid = threadIdx.x;
    for (int cb = blockIdx.x; cb < 192; cb += gridDim.x) {
        LAS float* sc = ldsf; LAS float* red = ldsf + 8192;
        for (int i = tid; i < 8192; i += NT) { const float v = c[i]; sc[i] = v * sigm(v); }
        __syncthreads();
        const int cc = tid & 31, kp = tid >> 5, j = cb * 32 + cc;
        float acc[8];
#pragma unroll
        for (int b = 0; b < 8; ++b) acc[b] = 0.f;
#pragma unroll 8
        for (int k = kp; k < 1024; k += 16) { const float wv = w_ada[(size_t)k * 6144 + j];
#pragma unroll
            for (int b = 0; b < 8; ++b) acc[b] += sc[b * 1024 + k] * wv; }
#pragma unroll
        for (int b = 0; b < 8; ++b) red[(kp * 8 + b) * 32 + cc] = acc[b];
        __syncthreads();
        if (tid < 256) { const int b = tid >> 5; float s = 0.f;
#pragma unroll
            for (int q = 0; q < 16; ++q) s += red[(q * 8 + b) * 32 + cc];
            MOD[b * 6144 + j] = s + b_ada[j]; }
        __syncthreads();
    }
}
__device__ __forceinline__ int rowmap(int mode, int n) {
    if (mode == 1) return n < 3344 ? n : n + 240;
    if (mode == 2) { const int j = n < 2816 ? n : n - 2816; return (j >> 7) * 256 + (n < 2816 ? 0 : 128) + (j & 127); }
    return n;
}
__device__ __forceinline__ void tr_item(const float* W, int K, int N, bf16* WT, int ldt, int koff, int row_off, int mode, LAS float* scr, int item, int lane) {
    const int nblk = (N + 31) / 32, kb = item / nblk, nb = item % nblk, k0 = 64 * kb, n0 = 32 * nb;
    const int ncol = n0 + (lane & 31); const bool okc = ncol < N;
#pragma unroll 8
    for (int i = 0; i < 32; ++i) { const int kk = 2 * i + (lane >> 5); scr[kk * 33 + (lane & 31)] = okc ? W[(size_t)(k0 + kk) * N + ncol] : 0.f; }
    LDS_WAIT();
    const int c = lane & 7;
#pragma unroll
    for (int j = 0; j < 4; ++j) { const int n = (lane >> 3) + 8 * j; const LAS float* s = scr + (8 * c) * 33 + n;
        u4 o; o.x = pk2(s[0 * 33], s[1 * 33]); o.y = pk2(s[2 * 33], s[3 * 33]); o.z = pk2(s[4 * 33], s[5 * 33]); o.w = pk2(s[6 * 33], s[7 * 33]);
        if (n0 + n < N) *(u4*)(WT + (size_t)(rowmap(mode, n0 + n) + row_off) * ldt + koff + k0 + 8 * c) = o; }
    LDS_WAIT();
}
__device__ __forceinline__ void p0_weights(const Args& a, LAS float* ldsf) {
    const int tid = threadIdx.x, lane = tid & 63, wave = tid >> 6;
    LAS float* scr = ldsf + wave * 4096;
    const int gw = blockIdx.x * NWAVE + wave, NGW = gridDim.x * NWAVE;
    bf16* WinT = (bf16*)(a.ws + WS_WIN); bf16* W1T = (bf16*)(a.ws + WS_W1); bf16* W2T = (bf16*)(a.ws + WS_W2); bf16* WbrT = (bf16*)(a.ws + WS_WBR); bf16* WmixT = (bf16*)(a.ws + WS_WMIX);
    constexpr int I_IN = 16 * 169, I_F1 = 16 * 176, I_F2 = 44 * 32, I_BR = 8 * 32, I_MX = 16 * 32;
    constexpr int NITEMS = I_IN + I_F1 + I_F2 + 2 * I_BR + 2 * I_MX;
    for (int it = gw; it < NITEMS; it += NGW) {
        int r = it;
        if (r < I_IN) { tr_item(a.in[4], 1024, NIN, WinT, 1024, 0, 0, 1, scr, r, lane); continue; } r -= I_IN;
        if (r < I_F1) { tr_item(a.in[24], 1024, 2 * DFF, W1T, 1024, 0, 0, 2, scr, r, lane); continue; } r -= I_F1;
        if (r < I_F2) { tr_item(a.in[25], DFF, 1024, W2T, DFF, 0, 0, 0, scr, r, lane); continue; } r -= I_F2;
        if (r < I_BR) { tr_item(a.in[19], 512, 1024, WbrT, 512, 0, 0, 0, scr, r, lane); continue; } r -= I_BR;
        if (r < I_BR) { tr_item(a.in[20], 512, 1024, WbrT, 512, 0, 1024, 0, scr, r, lane); continue; } r -= I_BR;
        if (r < I_MX) { tr_item(a.in[21], 1024, 1024, WmixT, 2048, 0, 0, 0, scr, r, lane); continue; } r -= I_MX;
        tr_item(a.in[21], 1024, 1024, WmixT, 2048, 1024, 0, 0, scr, r, lane);
    }
    const u4 z = {0u, 0u, 0u, 0u};
    for (int i = blockIdx.x * NT + tid; i < 240 * 128; i += gridDim.x * NT) *((u4*)(WinT + (size_t)3344 * 1024) + i) = z;
}
__device__ __forceinline__ void p1_modulate(const float* x, const float* MOD, bf16* U) {
    const int tid = threadIdx.x, lane = tid & 63, wave = tid >> 6;
    const int gw = blockIdx.x * NWAVE + wave, NGW = gridDim.x * NWAVE;
    for (int m = gw; m < M; m += NGW) {
        const int b = m >> 11; const f4* xr = (const f4*)(x + (size_t)m * D) + lane;
        const f4* sh = (const f4*)(MOD + b * 6144) + lane; const f4* sc = (const f4*)(MOD + b * 6144 + 1024) + lane;
        u2* o = (u2*)(U + (size_t)m * D) + lane;
#pragma unroll
        for (int j = 0; j < 4; ++j) { const f4 v = xr[64 * j], s = sc[64 * j], h = sh[64 * j]; const f4 r = v * (s + 1.0f) + h;
            u2 w; w.x = pk2(r.x, r.y); w.y = pk2(r.z, r.w); o[64 * j] = w; }
    }
}
__device__ __forceinline__ void p3_lora(const Args& a, LAS float* ldsf) {
    const int tid = threadIdx.x;
    const bf16* RWP = (const bf16*)(a.ws + WS_RWP);
    const float* mu = a.in[5]; const float* w0 = a.in[6]; const float* w2 = a.in[7]; const float* a0 = a.in[8]; const float* a2 = a.in[9]; const float* g2 = a.in[10];
    float* E = a.out; bf16* A = (bf16*)(a.out + (size_t)8 * MiB); bf16* G = (bf16*)(a.out + (size_t)12 * MiB);
    constexpr int TS = 36;
    LAS float* TW = ldsf; LAS float* TA = ldsf + 64 * TS; LAS float* TG = ldsf + 128 * TS;
    for (int tile = blockIdx.x; tile < M / 32; tile += gridDim.x) {
        const int m0 = tile * 32;
        __syncthreads();
#pragma unroll 4
        for (int i = 0; i < 16; ++i) { const int e = tid + i * NT, tl = e >> 8, ci = e & 255, col = 1536 + ci, m = m0 + tl;
            const float p = bf2f(RWP[(size_t)m * RWC + col]); const float pp = (m & 2047) ? bf2f(RWP[(size_t)(m - 1) * RWC + col]) : 0.f;
            const float ps = p + mu[col] * (pp - p);
            float v; if (ci < 64) v = tanhf(ps); else if (ci < 128) v = ps; else v = sigm(ps);
            ldsf[ci * TS + tl] = v; }
        __syncthreads();
        const int j = tid;
        f4 acc[8];
#pragma unroll
        for (int q = 0; q < 8; ++q) acc[q] = (f4){0.f, 0.f, 0.f, 0.f};
#pragma unroll 4
        for (int kk = 0; kk < 64; ++kk) { const float w = w2[kk * 512 + j];
#pragma unroll
            for (int q = 0; q < 8; ++q) acc[q] += *(const LAS f4*)(TW + kk * TS + 4 * q) * w; }
        { const float wj = w0[j];
#pragma unroll
          for (int q = 0; q < 8; ++q)
#pragma unroll
            for (int i = 0; i < 4; ++i) E[(size_t)(m0 + 4 * q + i) * 512 + j] = 0.6065306597126334f * sigm(wj + acc[q][i]); }
#pragma unroll
        for (int q = 0; q < 8; ++q) acc[q] = (f4){0.f, 0.f, 0.f, 0.f};
#pragma unroll 4
        for (int kk = 0; kk < 64; ++kk) { const float w = a2[kk * 512 + j];
#pragma unroll
            for (int q = 0; q < 8; ++q) acc[q] += *(const LAS f4*)(TA + kk * TS + 4 * q) * w; }
        { const float aj = a0[j];
#pragma unroll
          for (int q = 0; q < 8; ++q)
#pragma unroll
            for (int i = 0; i < 4; ++i) A[(size_t)(m0 + 4 * q + i) * 512 + j] = (bf16)f2bf(sigm(aj + acc[q][i])); }
#pragma unroll
        for (int q = 0; q < 8; ++q) acc[q] = (f4){0.f, 0.f, 0.f, 0.f};
#pragma unroll 4
        for (int kk = 0; kk < 128; ++kk) { const float w = g2[kk * 512 + j];
#pragma unroll
            for (int q = 0; q < 8; ++q) acc[q] += *(const LAS f4*)(TG + kk * TS + 4 * q) * w; }
#pragma unroll
        for (int q = 0; q < 8; ++q)
#pragma unroll
            for (int i = 0; i < 4; ++i) G[(size_t)(m0 + 4 * q + i) * 512 + j] = (bf16)f2bf(acc[q][i]);
    }
}
struct RwRaw { unsigned short rp[4], rq[4], kp[4], kq[4], vp[4], vq[4], av[4]; float ev[4]; };
__device__ __forceinline__ void rw_scan_unit(const Args& a, LAS float* ldsf, int unit) {
    const int tid = threadIdx.x, lane = tid & 63, wave = tid >> 6;
    const int bh = unit >> 1, half = unit & 1, b = bh >> 3, h = bh & 7;
    const bf16* RWP = (const bf16*)(a.ws + WS_RWP);
    const float* E = a.out; const bf16* A = (const bf16*)(a.out + (size_t)8 * MiB);
    float* SB = (float*)(a.ws + WS_SB); bf16* Yraw = (bf16*)(a.ws + WS_U);
    const float* mu = a.in[5];
    const int col = h * 64 + lane;
    const float mu_r = mu[col], mu_k = mu[512 + col], mu_v = mu[1024 + col];
    const float kkw = a.in[11][col], kaw = a.in[12][col], rkw = a.in[13][col];
    constexpr int BUF = 6 * 2048;
    LAS float* Ybuf = ldsf + 2 * BUF;
    const int rowl = tid >> 4, kq = tid & 15;
    float s0 = 0.f, s1 = 0.f, s2 = 0.f, s3 = 0.f;
    const size_t mb = (size_t)b * SEQ;
    RwRaw raw;
#define RW_LOAD(c) do { _Pragma("unroll") for (int i = 0; i < 4; ++i) { const int t = (c) * 32 + wave + 8 * i; const size_t m = mb + t; const bf16* p = RWP + m * RWC + col; \
        const bf16* q = t ? p - RWC : p; raw.rp[i] = p[0]; raw.kp[i] = p[512]; raw.vp[i] = p[1024]; raw.rq[i] = q[0]; raw.kq[i] = q[512]; raw.vq[i] = q[1024]; \
        raw.ev[i] = E[m * 512 + col]; raw.av[i] = A[m * 512 + col]; } } while (0)
#define RW_FINAL(c, buf) do { LAS float* B_ = ldsf + (buf) * BUF; _Pragma("unroll") for (int i = 0; i < 4; ++i) { const int tl = wave + 8 * i, t = (c) * 32 + tl; \
        const float rp = bf2f(raw.rp[i]), kp = bf2f(raw.kp[i]), vp = bf2f(raw.vp[i]); \
        const float rq = t ? bf2f(raw.rq[i]) : 0.f, kq_ = t ? bf2f(raw.kq[i]) : 0.f, vq = t ? bf2f(raw.vq[i]) : 0.f; \
        const float r = rp + mu_r * (rq - rp), k = kp + mu_k * (kq_ - kp), v = vp + mu_v * (vq - vp); \
        const float av = bf2f(raw.av[i]); const float dec = __expf(-raw.ev[i]); \
        const float kkv = k * kkw; const float n2 = wave_sum(kkv * kkv); const float kkn = kkv / fmaxf(sqrtf(n2), 1e-12f); \
        const float k2 = k * (1.f + (av - 1.f) * kaw); const float bb = kkn * av; \
        const float sb = wave_sum(r * k2 * rkw); if (half == 0 && lane == 0) SB[(mb + t) * 8 + h] = sb; \
        B_[0 * 2048 + tl * 64 + lane] = r; B_[1 * 2048 + tl * 64 + lane] = dec; B_[2 * 2048 + tl * 64 + lane] = k2; \
        B_[3 * 2048 + tl * 64 + lane] = v; B_[4 * 2048 + tl * 64 + lane] = kkn; B_[5 * 2048 + tl * 64 + lane] = bb; } } while (0)
    __syncthreads();
    RW_LOAD(0); RW_FINAL(0, 0);
    __syncthreads();
    for (int c = 0; c < 64; ++c) {
        if (c + 1 < 64) RW_LOAD(c + 1);
        const LAS float* Bc = ldsf + (c & 1) * BUF;
#pragma unroll 4
        for (int tl = 0; tl < 32; ++tl) {
            const f4 r4 = *(const LAS f4*)(Bc + 0 * 2048 + tl * 64 + 4 * kq), w4 = *(const LAS f4*)(Bc + 1 * 2048 + tl * 64 + 4 * kq), k4 = *(const LAS f4*)(Bc + 2 * 2048 + tl * 64 + 4 * kq);
            const f4 kk4 = *(const LAS f4*)(Bc + 4 * 2048 + tl * 64 + 4 * kq), b4 = *(const LAS f4*)(Bc + 5 * 2048 + tl * 64 + 4 * kq);
            const float v1 = Bc[3 * 2048 + tl * 64 + half * 32 + rowl];
            float p = s0 * kk4.x + s1 * kk4.y + s2 * kk4.z + s3 * kk4.w; p = reduce16(p); const float sa = -p;
            s0 = s0 * w4.x + sa * b4.x + v1 * k4.x; s1 = s1 * w4.y + sa * b4.y + v1 * k4.y; s2 = s2 * w4.z + sa * b4.z + v1 * k4.z; s3 = s3 * w4.w + sa * b4.w + v1 * k4.w;
            float y = s0 * r4.x + s1 * r4.y + s2 * r4.z + s3 * r4.w; y = reduce16(y);
            if (kq == 0) Ybuf[tl * 32 + rowl] = y;
        }
        __syncthreads();
        { const int idx = tid * 2, tl = idx >> 5, rl = idx & 31; const f2 yv = *(const LAS f2*)(Ybuf + idx);
          *(unsigned*)(Yraw + (mb + c * 32 + tl) * 512 + h * 64 + half * 32 + rl) = pk2(yv.x, yv.y); }
        if (c + 1 < 64) RW_FINAL(c + 1, (c + 1) & 1);
        __syncthreads();
    }
#undef RW_LOAD
#undef RW_FINAL
}
__device__ __forceinline__ void gla_unit(const Args& a, LAS float* ldsf, int unit) {
    const int tid = threadIdx.x, lane = tid & 63, wave = tid >> 6;
    const int bh = unit >> 2, vs = unit & 3, b = bh >> 2, h = bh & 3;
    const bf16* GLAP = (const bf16*)(a.ws + WS_GLAP); bf16* Oraw = (bf16*)(a.ws + WS_U + 16 * MiB);
    const float* ga2 = a.in[16]; const float* gab = a.in[17];
    constexpr int P = 68, PV = 36;
    LAS float* QS = ldsf; LAS float* KS = QS + 64 * P; LAS float* KD = KS + 64 * P; LAS float* ATT = KD + 64 * P;
    LAS float* VV = ATT + 64 * P; LAS float* SS = VV + 64 * PV; LAS float* AD = SS + 64 * PV; LAS float* DEC = AD + 1024;
    LAS float* LAT = ATT;
    const size_t mb = (size_t)b * SEQ;
    const int dd = tid & 63, tg = tid >> 6;
    float a2r[16];
#pragma unroll
    for (int j = 0; j < 16; ++j) a2r[j] = ga2[j * 256 + h * 64 + dd];
    const float abr = gab[h * 64 + dd];
    __syncthreads();
    for (int i = tid; i < 64 * PV; i += NT) SS[i] = 0.f;
    unsigned short rq[8], rk[8], rv[4], rad[2];
#define GLA_LOAD(c) do { const size_t m0 = mb + (size_t)(c) * 64; _Pragma("unroll") for (int i = 0; i < 8; ++i) { const int e = tid + NT * i, t = e >> 6, d = e & 63; const bf16* p = GLAP + (m0 + t) * GLCP + h * 64 + d; rq[i] = p[0]; rk[i] = p[256]; } \
        _Pragma("unroll") for (int i = 0; i < 4; ++i) { const int e = tid + NT * i, t = e >> 5, v = e & 31; rv[i] = GLAP[(m0 + t) * GLCP + 512 + h * 128 + vs * 32 + v]; } \
        _Pragma("unroll") for (int i = 0; i < 2; ++i) { const int e = tid + NT * i, t = e >> 4, j = e & 15; rad[i] = GLAP[(m0 + t) * GLCP + 1536 + j]; } } while (0)
#define GLA_STORE() do { _Pragma("unroll") for (int i = 0; i < 8; ++i) { const int e = tid + NT * i, t = e >> 6, d = e & 63; QS[t * P + d] = bf2f(rq[i]); KS[t * P + d] = bf2f(rk[i]); } \
        _Pragma("unroll") for (int i = 0; i < 4; ++i) { const int e = tid + NT * i, t = e >> 5, v = e & 31; VV[t * PV + v] = bf2f(rv[i]); } \
        _Pragma("unroll") for (int i = 0; i < 2; ++i) { const int e = tid + NT * i; AD[e] = bf2f(rad[i]); } } while (0)
    GLA_LOAD(0); GLA_STORE();
    __syncthreads();
    for (int c = 0; c < 32; ++c) {
        if (c + 1 < 32) GLA_LOAD(c + 1);
#pragma unroll
        for (int i = 0; i < 8; ++i) { const int t = tg * 8 + i; float z = abr;
#pragma unroll
            for (int j4 = 0; j4 < 4; ++j4) { const f4 av = *(const LAS f4*)(AD + t * 16 + 4 * j4); z += av.x * a2r[4 * j4] + av.y * a2r[4 * j4 + 1] + av.z * a2r[4 * j4 + 2] + av.w * a2r[4 * j4 + 3]; }
            const float ls = fminf(z, 0.f) - log1pf(__expf(-fabsf(z)));
            LAT[dd * 65 + t] = ls * 0.0625f; }
        __syncthreads();
#pragma unroll
        for (int i = 0; i < 8; ++i) { const int d = wave * 8 + i; float bcum = LAT[d * 65 + lane];
#pragma unroll
            for (int o = 1; o < 64; o <<= 1) { const float up = __shfl_up(bcum, o); if (lane >= o) bcum += up; }
            const float bl = __shfl(bcum, 63);
            const float qv = QS[lane * P + d], kv = KS[lane * P + d];
            QS[lane * P + d] = qv * 0.125f * __expf(bcum); KS[lane * P + d] = kv * __expf(-bcum); KD[lane * P + d] = kv * __expf(bl - bcum);
            if (lane == 0) DEC[d] = __expf(bl); }
        __syncthreads();
        { const int cr = tid >> 3, sg = tid & 7; float at[8];
#pragma unroll
          for (int i = 0; i < 8; ++i) at[i] = 0.f;
#pragma unroll 4
          for (int d = 0; d < 64; d += 4) { const f4 q4 = *(const LAS f4*)(QS + cr * P + d);
#pragma unroll
            for (int i = 0; i < 8; ++i) { const f4 k4 = *(const LAS f4*)(KS + (sg + 8 * i) * P + d); at[i] += q4.x * k4.x + q4.y * k4.y + q4.z * k4.z + q4.w * k4.w; } }
#pragma unroll
          for (int i = 0; i < 8; ++i) { const int s = sg + 8 * i; ATT[cr * P + s] = (s <= cr) ? at[i] : 0.f; } }
        __syncthreads();
        { const int cr = tid >> 3, vg = tid & 7; f4 o = (f4){0.f, 0.f, 0.f, 0.f};
#pragma unroll 4
          for (int s = 0; s < 64; s += 4) { const f4 a4 = *(const LAS f4*)(ATT + cr * P + s);
            o += *(const LAS f4*)(VV + (s + 0) * PV + 4 * vg) * a4.x; o += *(const LAS f4*)(VV + (s + 1) * PV + 4 * vg) * a4.y;
            o += *(const LAS f4*)(VV + (s + 2) * PV + 4 * vg) * a4.z; o += *(const LAS f4*)(VV + (s + 3) * PV + 4 * vg) * a4.w; }
#pragma unroll 4
          for (int d = 0; d < 64; d += 4) { const f4 q4 = *(const LAS f4*)(QS + cr * P + d);
            o += *(const LAS f4*)(SS + (d + 0) * PV + 4 * vg) * q4.x; o += *(const LAS f4*)(SS + (d + 1) * PV + 4 * vg) * q4.y;
            o += *(const LAS f4*)(SS + (d + 2) * PV + 4 * vg) * q4.z; o += *(const LAS f4*)(SS + (d + 3) * PV + 4 * vg) * q4.w; }
          u2 w; w.x = pk2(o.x, o.y); w.y = pk2(o.z, o.w);
          *(u2*)(Oraw + (mb + (size_t)c * 64 + cr) * 512 + h * 128 + vs * 32 + 4 * vg) = w; }
        __syncthreads();
        { const int d = tid >> 3, vg = tid & 7; f4 sv = *(const LAS f4*)(SS + d * PV + 4 * vg) * DEC[d];
#pragma unroll 8
          for (int cc = 0; cc < 64; ++cc) sv += *(const LAS f4*)(VV + cc * PV + 4 * vg) * KD[cc * P + d];
          *(LAS f4*)(SS + d * PV + 4 * vg) = sv; }
        __syncthreads();
        if (c + 1 < 32) GLA_STORE();
        __syncthreads();
    }
#undef GLA_LOAD
#undef GLA_STORE
}
__device__ __forceinline__ void p5_post(const Args& a) {
    const int tid = threadIdx.x, lane = tid & 63, wave = tid >> 6;
    const int gw = blockIdx.x * NWAVE + wave, NGW = gridDim.x * NWAVE;
    const bf16* RWP = (const bf16*)(a.ws + WS_RWP); const bf16* GLAP = (const bf16*)(a.ws + WS_GLAP);
    bf16* Yraw = (bf16*)(a.ws + WS_U); bf16* Oraw = (bf16*)(a.ws + WS_U + 16 * MiB);
    const bf16* G = (const bf16*)(a.out + (size_t)12 * MiB); const float* SB = (const float*)(a.ws + WS_SB);
    const float* mu = a.in[5]; const float* gng = a.in[14]; const float* gnb = a.in[15]; const float* nrm = a.in[18];
    const float ng0 = nrm[lane], ng1 = nrm[64 + lane];
    for (int m = gw; m < M; m += NGW) {
        const int t = m & 2047;
#pragma unroll
        for (int h = 0; h < 8; ++h) { const int col = h * 64 + lane;
            const float y = bf2f(Yraw[(size_t)m * 512 + col]);
            const float vp = bf2f(RWP[(size_t)m * RWC + 1024 + col]); const float vq = t ? bf2f(RWP[(size_t)(m - 1) * RWC + 1024 + col]) : 0.f;
            const float v = vp + mu[1024 + col] * (vq - vp);
            const float g = bf2f(G[(size_t)m * 512 + col]); const float sb = SB[(size_t)m * 8 + h];
            const float mean = wave_sum(y) * (1.f / 64.f); const float dl = y - mean; const float var = wave_sum(dl * dl) * (1.f / 64.f);
            const float yn = dl * rsqrtf(var + GN_EPS) * gng[col] + gnb[col];
            Yraw[(size_t)m * 512 + col] = (bf16)f2bf((yn + sb * v) * g); }
#pragma unroll
        for (int h = 0; h < 4; ++h) { const int c0 = h * 128 + lane, c1 = c0 + 64;
            const float o0 = bf2f(Oraw[(size_t)m * 512 + c0]), o1 = bf2f(Oraw[(size_t)m * 512 + c1]);
            const float g0 = bf2f(GLAP[(size_t)m * GLCP + 1024 + c0]), g1 = bf2f(GLAP[(size_t)m * GLCP + 1024 + c1]);
            const float ms = wave_sum(o0 * o0 + o1 * o1) * (1.f / 128.f); const float rs = rsqrtf(ms + GLA_EPS);
            Oraw[(size_t)m * 512 + c0] = (bf16)f2bf(o0 * rs * ng0 * g0 * sigm(g0)); Oraw[(size_t)m * 512 + c1] = (bf16)f2bf(o1 * rs * ng1 * g1 * sigm(g1)); }
    }
}
__device__ __forceinline__ void ln_rows(float* X, const float* g, const float* bta, const float* MOD, bf16* U2) {
    const int tid = threadIdx.x, lane = tid & 63, wave = tid >> 6;
    const int gw = blockIdx.x * NWAVE + wave, NGW = gridDim.x * NWAVE;
    for (int m = gw; m < M; m += NGW) {
        f4* xr = (f4*)(X + (size_t)m * D) + lane; f4 v[4]; float s = 0.f;
#pragma unroll
        for (int j = 0; j < 4; ++j) { v[j] = xr[64 * j]; s += (v[j].x + v[j].y) + (v[j].z + v[j].w); }
        const float mean = wave_sum(s) * (1.f / D); float s2 = 0.f;
#pragma unroll
        for (int j = 0; j < 4; ++j) { v[j] = v[j] - mean; s2 += (v[j].x * v[j].x + v[j].y * v[j].y) + (v[j].z * v[j].z + v[j].w * v[j].w); }
        const float rstd = rsqrtf(wave_sum(s2) * (1.f / D) + LN_EPS);
        const int b = m >> 11;
#pragma unroll
        for (int j = 0; j < 4; ++j) { const f4 gg = ((const f4*)g)[lane + 64 * j], bb = ((const f4*)bta)[lane + 64 * j]; const f4 r = v[j] * rstd * gg + bb; xr[64 * j] = r;
            if (U2) { const f4 sh = ((const f4*)(MOD + b * 6144 + 3072))[lane + 64 * j], sc = ((const f4*)(MOD + b * 6144 + 4096))[lane + 64 * j]; const f4 uu = r * (sc + 1.0f) + sh;
                u2 w; w.x = pk2(uu.x, uu.y); w.y = pk2(uu.z, uu.w); ((u2*)(U2 + (size_t)m * D))[lane + 64 * j] = w; } }
    }
}

__global__ void __launch_bounds__(NT, 2) fwd_mega(Args a) {
    extern __shared__ __attribute__((aligned(16))) unsigned char lds[];
    cg::grid_group grid = cg::this_grid();
    LAS unsigned char* L = (LAS unsigned char*)lds; LAS float* ldsf = (LAS float*)lds;
    unsigned char* ws = a.ws;
    float* MOD = (float*)(ws + WS_MOD);
    bf16* U = (bf16*)(ws + WS_U);
    const int G = gridDim.x;
    p0_mod(a.in[1], a.in[2], a.in[3], MOD, ldsf);
    p0_weights(a, ldsf);
    grid.sync();
    p1_modulate(a.in[0], MOD, U);
    grid.sync();
    { pg8::Gemm g{U, (const bf16*)(ws + WS_WIN), M, NPROJ, D, U, 1 << 30}; pg8::StaticOrder S; S.init(M, NPROJ, G, (int)blockIdx.x);
      EpiProj E{(bf16*)(ws + WS_RWP), (bf16*)(ws + WS_GLAP), (bf16*)(ws + WS_GATES)};
      pg8::gemm_phase<EpiProj, pg8::StaticOrder, true, true>(L, g, S, E); }
    grid.sync();
    p3_lora(a, ldsf);
    grid.sync();
    for (int unit = blockIdx.x; unit < 256; unit += G) { if (unit < 128) rw_scan_unit(a, ldsf, unit); else gla_unit(a, ldsf, unit - 128); }
    grid.sync();
    p5_post(a);
    grid.sync();
    { pg8::Gemm g{U, (const bf16*)(ws + WS_WBR), M, 2048, 512, (const bf16*)(ws + WS_U + 16 * MiB), 4}; pg8::StaticOrder S; S.init(M, 2048, G, (int)blockIdx.x);
      EpiGate E{(bf16*)(ws + WS_MG), (const bf16*)(ws + WS_GATES)};
      pg8::gemm_phase<EpiGate, pg8::StaticOrder, true, true>(L, g, S, E); }
    grid.sync();
    { pg8::Gemm g{(const bf16*)(ws + WS_MG), (const bf16*)(ws + WS_WMIX), M, D, 2048, (const bf16*)(ws + WS_MG), 1 << 30}; pg8::StaticOrder S; S.init(M, D, G, (int)blockIdx.x);
      EpiRes E{a.in[0], a.out, MOD + 2048};
      pg8::gemm_phase<EpiRes, pg8::StaticOrder, true, true>(L, g, S, E); }
    grid.sync();
    ln_rows(a.out, a.in[22], a.in[23], MOD, U);
    grid.sync();
    { pg8::Gemm g{U, (const bf16*)(ws + WS_W1), M, 2 * DFF, D, U, 1 << 30}; pg8::StaticOrder S; S.init(M, 2 * DFF, G, (int)blockIdx.x);
      EpiSwiGLU E{(bf16*)(ws + WS_H)};
      pg8::gemm_phase<EpiSwiGLU, pg8::StaticOrder, true, true>(L, g, S, E); }
    grid.sync();
    { pg8::Gemm g{(const bf16*)(ws + WS_H), (const bf16*)(ws + WS_W2), M, D, DFF, (const bf16*)(ws + WS_H), 1 << 30}; pg8::StaticOrder S; S.init(M, D, G, (int)blockIdx.x);
      EpiRes E{a.out, a.out, MOD + 5120};
      pg8::gemm_phase<EpiRes, pg8::StaticOrder, true, true>(L, g, S, E); }
    grid.sync();
    ln_rows(a.out, a.in[26], a.in[27], MOD, nullptr);
}

extern "C" void kernel_launch(void* const* d_in, const int* in_sizes, int n_in, void* d_out, int out_size, void* d_ws, size_t ws_size, hipStream_t stream) {
    static int grid = 0;
    if (grid == 0) {
        int dev = 0, cus = 0, per_cu = 0;
        hipGetDevice(&dev);
        hipDeviceGetAttribute(&cus, hipDeviceAttributeMultiprocessorCount, dev);
        if (hipFuncSetAttribute((const void*)fwd_mega, hipFuncAttributeMaxDynamicSharedMemorySize, LDS_BYTES) != hipSuccess) fprintf(stderr, "hipFuncSetAttribute failed\n");
        if (hipOccupancyMaxActiveBlocksPerMultiprocessor(&per_cu, (const void*)fwd_mega, NT, LDS_BYTES) != hipSuccess || per_cu < 1) { fprintf(stderr, "occupancy query: %d\n", per_cu); per_cu = 1; }
        (void)hipGetLastError();
        grid = cus * 1;
        if (grid <= 0) grid = 256;
    }
    Args a{};
    for (int i = 0; i < 28; ++i) a.in[i] = (const float*)d_in[i];
    a.out = (float*)d_out; a.ws = (unsigned char*)d_ws;
    void* args[] = {&a};
    hipError_t e = hipLaunchCooperativeKernel((const void*)fwd_mega, dim3(grid), dim3(NT), args, LDS_BYTES, stream);
    if (e != hipSuccess) fprintf(stderr, "cooperative launch failed: %s (grid %d)\n", hipGetErrorString(e), grid);
}
```

```cpp
#include <hip/hip_runtime.h>
#include <hip/hip_cooperative_groups.h>
#include <cstdio>
#include <cstdint>
namespace cg = cooperative_groups;
namespace pg8 {
#define PG8_LAS __attribute__((address_space(3)))
typedef unsigned short bf16_t;
typedef short bf16x8 __attribute__((ext_vector_type(8)));
typedef float f32x4 __attribute__((ext_vector_type(4)));
typedef unsigned u32x4 __attribute__((ext_vector_type(4)));
constexpr int BM = 256, BK = 64, HALF = 128, HTB = HALF * BK * 2  , STAGE_BYTES = 8 * HTB, NXCD = 8, WGM = 8;

__host__ __device__ __forceinline__ int lds_byte(int r, int c) { const int st = (r >> 4) * 2 + (c >> 5), rr = r & 15, cc = c & 31, ob = rr * 64 + cc * 2; return st * 1024 + (ob ^ (((ob >> 9) & 1) << 5)); }
__host__ __device__ __forceinline__ void stage_rc(int b, int& R, int& C) { const int st = b / 1024, sb = b % 1024, swz = sb ^ (((sb >> 9) & 1) << 5); R = (st >> 1) * 16 + swz / 64; C = (st & 1) * 32 + (swz % 64) / 2; }
__host__ __device__ __forceinline__ int perm32(int rho) { const int n = rho >> 4, i = rho & 15; return 8 * (i >> 2) + 4 * n + (i & 3); }

struct Unit { int pm, pn; };
struct Gemm { const bf16_t* A; const bf16_t* Bt; int M, N, K; const bf16_t* A2; int nsplit; };

struct StaticOrder {
    int nM, nN, nwg, G, c;
    __host__ __device__ void init(int M, int N, int G_, int c_) { nM = M / BM; nN = N / BM; nwg = nM * nN; G = G_; c = c_; }
    __host__ __device__ bool next(int i, Unit& u) const {
        const long L = (long)i * G + c; if (L >= nwg) return false;
        int wgid = (int)L; { const int q = nwg / NXCD, r = nwg % NXCD, xcd = wgid % NXCD, off = wgid / NXCD; wgid = (xcd < r ? xcd * (q + 1) : r * (q + 1) + (xcd - r) * q) + off; }
        const int nig = WGM * nN, gid = wgid / nig, fm = gid * WGM, gsz = (nM - fm) < WGM ? (nM - fm) : WGM;
        u.pm = fm + ((wgid % nig) % gsz); u.pn = (wgid % nig) / gsz; return true;
    }
    __device__ __forceinline__ void a_ready(const Unit&) const {}
    __device__ __forceinline__ void done(const Unit&) const {}
};

__device__ __forceinline__ unsigned cvt_pk_bf16(float lo, float hi) { unsigned r; asm volatile("v_cvt_pk_bf16_f32 %0, %1, %2" : "=v"(r) : "v"(lo), "v"(hi)); return r; }
typedef float f32x2 __attribute__((ext_vector_type(2)));
template <class Epi, class Sched, bool ALIGN_EPI = false, bool SP2 = false>
__device__ __forceinline__ void gemm_phase(PG8_LAS unsigned char* lds, const Gemm g, const Sched& S, const Epi& E) {
    const int tid = threadIdx.x, wid = __builtin_amdgcn_readfirstlane(tid >> 6), lane = tid & 63, wr = wid >> 2, wc = wid & 3, fr = lane & 15, fq = lane >> 4;
    const int K = g.K, nt = K / BK;
    unsigned voffA[2], voffB[2];
#pragma unroll
    for (int i = 0; i < 2; ++i) { int R, C; stage_rc(tid * 16 + i * 8192, R, C); const int Rb = Epi::PERM ? ((R & ~31) + perm32(R & 31)) : R;
        voffA[i] = (unsigned)(R * K + C) * 2u; voffB[i] = (unsigned)(Rb * K + C) * 2u; }
    const size_t kstep = (size_t)(BK * 2);
    const size_t hstep = (size_t)HALF * K * 2;
    const size_t tstep = 2 * hstep;
    const unsigned ldsw = (unsigned)wid * 1024u;
    const int aoff = lds_byte(wr * 64 + fr, fq * 8), boff = lds_byte(wc * 32 + fr, fq * 8);
#define PG8_SA(b, h) (((b) * 2 + (h)) * HTB)
#define PG8_SB(b, h) ((4 + (b) * 2 + (h)) * HTB)
#define PG8_STAGE(bufoff, gbase, voff) do { _Pragma("unroll") for (int _i = 0; _i < 2; ++_i) \
        __builtin_amdgcn_global_load_lds((const unsigned*)((const char*)(gbase) + (voff)[_i]), (PG8_LAS unsigned*)(lds + (bufoff) + ldsw + _i * 8192), 16, 0, 0); } while (0)
#define PG8_LDA(dst, b, h) do { _Pragma("unroll") for (int m = 0; m < 4; ++m) _Pragma("unroll") for (int k = 0; k < 2; ++k) dst[m][k] = *(const PG8_LAS bf16x8*)(lds + PG8_SA(b, h) + aoff + m * 2048 + k * 1024); } while (0)
#define PG8_LDB(dst, b, h) do { _Pragma("unroll") for (int n = 0; n < 2; ++n) _Pragma("unroll") for (int k = 0; k < 2; ++k) dst[n][k] = *(const PG8_LAS bf16x8*)(lds + PG8_SB(b, h) + boff + n * 2048 + k * 1024); } while (0)
#define PG8_MMA(ai, bj, At, Bt) do { __builtin_amdgcn_s_setprio(1); _Pragma("unroll") for (int m = 0; m < 4; ++m) _Pragma("unroll") for (int n = 0; n < 2; ++n) _Pragma("unroll") for (int k = 0; k < 2; ++k) \
        acc[ai][bj][m][n] = __builtin_amdgcn_mfma_f32_16x16x32_bf16(Bt[n][k], At[m][k], acc[ai][bj][m][n], 0, 0, 0); __builtin_amdgcn_s_setprio(0); } while (0)
#define PG8_WAIT_V(n) asm volatile("s_waitcnt vmcnt(" #n ")" ::: "memory")
#define PG8_WAIT_L(n) asm volatile("s_waitcnt lgkmcnt(" #n ")" ::: "memory")
#define PG8_BAR __builtin_amdgcn_s_barrier()
#define PG8_SCHED __builtin_amdgcn_sched_barrier(0)
    Unit cur, nxt; int ui = 0;
    if (!S.next(0, cur)) return;
    f32x4 acc[2][2][4][2];
#pragma unroll
    for (int a = 0; a < 2; ++a)
#pragma unroll
        for (int b = 0; b < 2; ++b)
#pragma unroll
            for (int m = 0; m < 4; ++m)
#pragma unroll
                for (int n = 0; n < 2; ++n) acc[a][b][m][n] = (f32x4){0.f, 0.f, 0.f, 0.f};
    bf16x8 At[4][2], B0[2][2], B1[2][2];
    const char* cA = (const char*)(cur.pn >= g.nsplit ? g.A2 : g.A) + (size_t)cur.pm * tstep; const char* cB = (const char*)g.Bt + (size_t)cur.pn * tstep;
    S.a_ready(cur);
    if constexpr (SP2) {
        PG8_STAGE(PG8_SB(0, 0), cB, voffB); PG8_STAGE(PG8_SB(0, 1), cB + hstep, voffB); PG8_STAGE(PG8_SA(0, 0), cA, voffA); PG8_STAGE(PG8_SA(0, 1), cA + hstep, voffA);
        if (wr == 1) PG8_BAR;
        PG8_WAIT_V(2); PG8_BAR;
        PG8_STAGE(PG8_SB(1, 0), cB + kstep, voffB); PG8_STAGE(PG8_SA(1, 0), cA + kstep, voffA); PG8_STAGE(PG8_SB(1, 1), cB + hstep + kstep, voffB);
        PG8_WAIT_V(6); PG8_BAR;
    } else {
        PG8_STAGE(PG8_SB(0, 0), cB, voffB); PG8_STAGE(PG8_SA(0, 0), cA, voffA); PG8_STAGE(PG8_SB(0, 1), cB + hstep, voffB); PG8_STAGE(PG8_SA(0, 1), cA + hstep, voffA);
        if (wr == 1) PG8_BAR;
        PG8_WAIT_V(4); PG8_BAR;
        PG8_STAGE(PG8_SB(1, 0), cB + kstep, voffB); PG8_STAGE(PG8_SA(1, 0), cA + kstep, voffA); PG8_STAGE(PG8_SB(1, 1), cB + hstep + kstep, voffB);
        PG8_WAIT_V(6); PG8_BAR;
    }
    for (;;) {
        const bool has_next = S.next(ui + 1, nxt);
        const char* nA = has_next ? (const char*)(nxt.pn >= g.nsplit ? g.A2 : g.A) + (size_t)nxt.pm * tstep : cA; const char* nB = has_next ? (const char*)g.Bt + (size_t)nxt.pn * tstep : cB;
        for (int t = 0; t < nt; t += 2) {
            const bool last = (t == nt - 2);
            const char* a1 = cA + (size_t)(t + 1) * kstep;
            const char* a2 = last ? nA : cA + (size_t)(t + 2) * kstep; const char* b2 = last ? nB : cB + (size_t)(t + 2) * kstep;
            const char* a3 = a2 + kstep; const char* b3 = b2 + kstep;
            if (last && has_next) S.a_ready(nxt);
            if constexpr (SP2) {
            PG8_LDB(B0, 0, 0); PG8_LDB(B1, 0, 1); PG8_SCHED; PG8_LDA(At, 0, 0); PG8_STAGE(PG8_SA(1, 1), a1 + hstep, voffA);
            PG8_WAIT_V(8); PG8_WAIT_L(0); PG8_BAR; PG8_MMA(0, 0, At, B0); PG8_MMA(0, 1, At, B1); PG8_BAR; PG8_SCHED;
            PG8_LDA(At, 0, 1); PG8_STAGE(PG8_SB(0, 0), b2, voffB); PG8_STAGE(PG8_SB(0, 1), b2 + hstep, voffB); PG8_STAGE(PG8_SA(0, 0), a2, voffA);
            PG8_WAIT_V(8); PG8_WAIT_L(0); PG8_BAR; PG8_MMA(1, 0, At, B0); PG8_MMA(1, 1, At, B1); PG8_BAR; PG8_SCHED;
            PG8_LDB(B0, 1, 0); PG8_LDB(B1, 1, 1); PG8_SCHED; PG8_LDA(At, 1, 0); PG8_STAGE(PG8_SA(0, 1), a2 + hstep, voffA);
            PG8_WAIT_V(8); PG8_WAIT_L(0); PG8_BAR; PG8_MMA(0, 0, At, B0); PG8_MMA(0, 1, At, B1); PG8_BAR; PG8_SCHED;
            PG8_LDA(At, 1, 1); PG8_STAGE(PG8_SB(1, 0), b3, voffB); PG8_STAGE(PG8_SB(1, 1), b3 + hstep, voffB); PG8_STAGE(PG8_SA(1, 0), a3, voffA);
            PG8_WAIT_V(8); PG8_WAIT_L(0); PG8_BAR; PG8_MMA(1, 0, At, B0); PG8_MMA(1, 1, At, B1); PG8_BAR; PG8_SCHED;
            } else {
            PG8_LDB(B0, 0, 0); PG8_SCHED; PG8_LDA(At, 0, 0); PG8_STAGE(PG8_SA(1, 1), a1 + hstep, voffA);
            PG8_WAIT_L(8); PG8_BAR; PG8_WAIT_L(0); PG8_MMA(0, 0, At, B0); PG8_BAR; PG8_SCHED;
            PG8_LDB(B1, 0, 1); PG8_STAGE(PG8_SB(0, 0), b2, voffB);
            PG8_BAR; PG8_WAIT_L(0); PG8_MMA(0, 1, At, B1); PG8_BAR;
            PG8_LDA(At, 0, 1); PG8_STAGE(PG8_SA(0, 0), a2, voffA);
            PG8_BAR; PG8_WAIT_L(0); PG8_MMA(1, 0, At, B0); PG8_BAR; PG8_SCHED;
            PG8_STAGE(PG8_SB(0, 1), b2 + hstep, voffB);
            PG8_WAIT_V(6); PG8_BAR; PG8_MMA(1, 1, At, B1); PG8_BAR;
            PG8_LDB(B0, 1, 0); PG8_SCHED; PG8_LDA(At, 1, 0); PG8_STAGE(PG8_SA(0, 1), a2 + hstep, voffA);
            PG8_WAIT_L(8); PG8_BAR; PG8_WAIT_L(0); PG8_MMA(0, 0, At, B0); PG8_BAR; PG8_SCHED;
            PG8_LDB(B1, 1, 1); PG8_STAGE(PG8_SB(1, 0), b3, voffB);
            PG8_BAR; PG8_WAIT_L(0); PG8_MMA(0, 1, At, B1); PG8_BAR;
            PG8_LDA(At, 1, 1); PG8_STAGE(PG8_SA(1, 0), a3, voffA);
            PG8_BAR; PG8_WAIT_L(0); PG8_MMA(1, 0, At, B0); PG8_BAR; PG8_SCHED;
            PG8_STAGE(PG8_SB(1, 1), b3 + hstep, voffB);
            PG8_WAIT_V(6); PG8_BAR; PG8_MMA(1, 1, At, B1); PG8_BAR;
            }
        }
        if constexpr (ALIGN_EPI) { if (wr == 0) PG8_BAR; }
        if constexpr (!Epi::AFTER_DRAIN) { E(acc, cur, wr, wc, fr, fq); S.done(cur); }
        if (!has_next) break;
#pragma unroll
        for (int a = 0; a < 2; ++a)
#pragma unroll
            for (int b = 0; b < 2; ++b)
#pragma unroll
                for (int m = 0; m < 4; ++m)
#pragma unroll
                    for (int n = 0; n < 2; ++n) acc[a][b][m][n] = (f32x4){0.f, 0.f, 0.f, 0.f};
        cur = nxt; cA = nA; cB = nB; ++ui;
        if constexpr (ALIGN_EPI) { if (wr == 1) PG8_BAR; }
    }
    PG8_WAIT_V(0);
    if constexpr (!ALIGN_EPI) { if (wr == 0) PG8_BAR; }
    PG8_BAR;
    if constexpr (Epi::AFTER_DRAIN) { E.fused(acc, cur, wr, wc, fr, fq, lds, wid, lane); S.done(cur); }
#undef PG8_SA
#undef PG8_SB
#undef PG8_STAGE
#undef PG8_LDA
#undef PG8_LDB
#undef PG8_MMA
#undef PG8_WAIT_V
#undef PG8_WAIT_L
#undef PG8_BAR
#undef PG8_SCHED
}
}
#ifndef REP_RW
#define REP_RW 1
#endif
#ifndef REP_GLA
#define REP_GLA 1
#endif

#define LAS __attribute__((address_space(3)))
typedef unsigned short bf16;
typedef float f4 __attribute__((ext_vector_type(4)));
typedef float f2 __attribute__((ext_vector_type(2)));
typedef unsigned u4 __attribute__((ext_vector_type(4)));
typedef unsigned u2 __attribute__((ext_vector_type(2)));

constexpr int NT = 512, NWAVE = 8;
constexpr int D = 1024, NBATCH = 8, SEQ = 2048, M = NBATCH * SEQ;
constexpr int RWC = 1792, GLCP = 1792, NGATE = 2048, NPROJ = 5632, NIN = 5392, DFF = 2816;
constexpr float ALPHA = 1.189207115002721f, LN_EPS = 1e-5f, GN_EPS = 64e-5f, GLA_EPS = 1e-5f;
constexpr int LDS_BYTES = 147456;

constexpr size_t MiB = 1u << 20;
constexpr size_t WS_MOD = 0, WS_SB = 1 * MiB, WS_WIN = 2 * MiB, WS_W1 = 13 * MiB, WS_W2 = 24 * MiB, WS_WBR = 30 * MiB, WS_WMIX = 32 * MiB,
                 WS_U = 36 * MiB, WS_RWP = 68 * MiB, WS_GLAP = 124 * MiB, WS_GATES = 180 * MiB, WS_MG = 68 * MiB, WS_H = 68 * MiB,
                 WS_DECG = 1 * MiB + 512 * 1024, WS_KDT = 244 * MiB, WS_INVN = 252 * MiB;

__device__ __forceinline__ unsigned f2bf(float f) { unsigned u = __builtin_bit_cast(unsigned, f); return (u + 0x7fffu + ((u >> 16) & 1u)) >> 16; }
__device__ __forceinline__ unsigned pk2(float lo, float hi) { return f2bf(lo) | (f2bf(hi) << 16); }
__device__ __forceinline__ float bf2f(unsigned short b) { return __builtin_bit_cast(float, ((unsigned)b) << 16); }
__device__ __forceinline__ float bflo(unsigned w) { return __builtin_bit_cast(float, w << 16); }
__device__ __forceinline__ float bfhi(unsigned w) { return __builtin_bit_cast(float, w & 0xffff0000u); }
__device__ __forceinline__ float sigm(float x) { return 1.f / (1.f + __expf(-x)); }
__device__ __forceinline__ float wave_sum(float v) {
#pragma unroll
    for (int o = 1; o < 64; o <<= 1) v += __shfl_xor(v, o);
    return v;
}
template <int CTRL> __device__ __forceinline__ float dppf(float x) { return __builtin_bit_cast(float, __builtin_amdgcn_mov_dpp(__builtin_bit_cast(int, x), CTRL, 0xf, 0xf, true)); }
__device__ __forceinline__ float reduce16(float x) { x += dppf<0xB1>(x); x += dppf<0x4E>(x); x += dppf<0x141>(x); x += dppf<0x128>(x); return x; }
#define LDS_WAIT() asm volatile("s_waitcnt lgkmcnt(0)" ::: "memory")

struct Args { const float* in[28]; float* out; unsigned char* ws; };

struct EpiProj {
    static constexpr bool PERM = true, AFTER_DRAIN = false;
    bf16 *RWP, *GLAP, *GATES;
    __device__ __forceinline__ void operator()(const pg8::f32x4 (&acc)[2][2][4][2], const pg8::Unit& u, int wr, int wc, int fr, int fq) const {
        bf16* base; int ldc, colt; bool sg;
        if (u.pn < 7) { base = RWP; ldc = RWC; colt = u.pn * 256; sg = false; }
        else if (u.pn < 14) { base = GLAP; ldc = GLCP; colt = (u.pn - 7) * 256; sg = false; }
        else { base = GATES; ldc = NGATE; colt = (u.pn - 14) * 256; sg = true; }
        const int row0 = u.pm * 256 + wr * 64 + fr, col0 = colt + wc * 32 + 8 * fq;
#pragma unroll
        for (int ai = 0; ai < 2; ++ai)
#pragma unroll
            for (int m = 0; m < 4; ++m) { bf16* rowp = base + (size_t)(row0 + ai * 128 + m * 16) * ldc + col0;
#pragma unroll
                for (int bj = 0; bj < 2; ++bj) { pg8::f32x4 v0 = acc[ai][bj][m][0], v1 = acc[ai][bj][m][1];
                    if (sg) {
#pragma unroll
                        for (int j = 0; j < 4; ++j) { v0[j] = sigm(v0[j]); v1[j] = sigm(v1[j]); } }
                    u4 w; w.x = pk2(v0[0], v0[1]); w.y = pk2(v0[2], v0[3]); w.z = pk2(v1[0], v1[1]); w.w = pk2(v1[2], v1[3]);
                    *(u4*)(rowp + bj * 128) = w; } }
    }
};
struct EpiGate {
    static constexpr bool PERM = true, AFTER_DRAIN = false;
    bf16* MG; const bf16* GATES;
    __device__ __forceinline__ void operator()(const pg8::f32x4 (&acc)[2][2][4][2], const pg8::Unit& u, int wr, int wc, int fr, int fq) const {
        const int row0 = u.pm * 256 + wr * 64 + fr, col0 = u.pn * 256 + wc * 32 + 8 * fq;
#pragma unroll
        for (int ai = 0; ai < 2; ++ai)
#pragma unroll
            for (int m = 0; m < 4; ++m) { const size_t off = (size_t)(row0 + ai * 128 + m * 16) * NGATE + col0;
#pragma unroll
                for (int bj = 0; bj < 2; ++bj) { const pg8::f32x4 v0 = acc[ai][bj][m][0], v1 = acc[ai][bj][m][1];
                    const u4 gt = *(const u4*)(GATES + off + bj * 128);
                    u4 w; w.x = pk2(v0[0] * bflo(gt.x), v0[1] * bfhi(gt.x)); w.y = pk2(v0[2] * bflo(gt.y), v0[3] * bfhi(gt.y));
                    w.z = pk2(v1[0] * bflo(gt.z), v1[1] * bfhi(gt.z)); w.w = pk2(v1[2] * bflo(gt.w), v1[3] * bfhi(gt.w));
                    *(u4*)(MG + off + bj * 128) = w; } }
    }
};
struct EpiRes {
    static constexpr bool PERM = false, AFTER_DRAIN = false;
    const float* base; float* out; const float* gate;
    __device__ __forceinline__ void operator()(const pg8::f32x4 (&acc)[2][2][4][2], const pg8::Unit& u, int wr, int wc, int fr, int fq) const {
        const int row0 = u.pm * 256 + wr * 64 + fr, col0 = u.pn * 256 + wc * 32 + 4 * fq;
        const float* gp = gate + (size_t)(u.pm >> 3) * 6144 + col0;
        pg8::f32x4 gv[2][2];
#pragma unroll
        for (int bj = 0; bj < 2; ++bj)
#pragma unroll
            for (int n = 0; n < 2; ++n) gv[bj][n] = *(const pg8::f32x4*)(gp + bj * 128 + n * 16);
#pragma unroll
        for (int ai = 0; ai < 2; ++ai)
#pragma unroll
            for (int m = 0; m < 4; ++m) { const size_t off = (size_t)(row0 + ai * 128 + m * 16) * D + col0;
#pragma unroll
                for (int bj = 0; bj < 2; ++bj)
#pragma unroll
                    for (int n = 0; n < 2; ++n) { const pg8::f32x4 bs = *(const pg8::f32x4*)(base + off + bj * 128 + n * 16);
                        *(pg8::f32x4*)(out + off + bj * 128 + n * 16) = bs * ALPHA + gv[bj][n] * acc[ai][bj][m][n]; } }
    }
};
struct EpiSwiGLU {
    static constexpr bool PERM = true, AFTER_DRAIN = false;
    bf16* H;
    __device__ __forceinline__ void operator()(const pg8::f32x4 (&acc)[2][2][4][2], const pg8::Unit& u, int wr, int wc, int fr, int fq) const {
        const int row0 = u.pm * 256 + wr * 64 + fr, col0 = u.pn * 128 + wc * 32 + 8 * fq;
#pragma unroll
        for (int ai = 0; ai < 2; ++ai)
#pragma unroll
            for (int m = 0; m < 4; ++m) { bf16* rowp = H + (size_t)(row0 + ai * 128 + m * 16) * DFF + col0;
                float h[8];
#pragma unroll
                for (int n = 0; n < 2; ++n)
#pragma unroll
                    for (int j = 0; j < 4; ++j) { const float g = acc[ai][0][m][n][j], up = acc[ai][1][m][n][j]; h[n * 4 + j] = g * sigm(g) * up; }
                u4 w; w.x = pk2(h[0], h[1]); w.y = pk2(h[2], h[3]); w.z = pk2(h[4], h[5]); w.w = pk2(h[6], h[7]);
                *(u4*)rowp = w; }
    }
};

__device__ __forceinline__ void p0_mod(const float* c, const float* w_ada, const float* b_ada, float* MOD, LAS float* ldsf) {
    const int tid = threadIdx.x;
    for (int cb = blockIdx.x; cb < 192; cb += gridDim.x) {
        LAS float* sc = ldsf; LAS float* red = ldsf + 8192;
        for (int i = tid; i < 8192; i += NT) { const float v = c[i]; sc[i] = v * sigm(v); }
        __syncthreads();
        const int cc = tid & 31, kp = tid >> 5, j = cb * 32 + cc;
        float acc[8];
#pragma unroll
        for (int b = 0; b < 8; ++b) acc[b] = 0.f;
#pragma unroll 8
        for (int k = kp; k < 1024; k += 16) { const float wv = w_ada[(size_t)k * 6144 + j];
#pragma unroll
            for (int b = 0; b < 8; ++b) acc[b] += sc[b * 1024 + k] * wv; }
#pragma unroll
        for (int b = 0; b < 8; ++b) red[(kp * 8 + b) * 32 + cc] = acc[b];
        __syncthreads();
        if (tid < 256) { const int b = tid >> 5; float s = 0.f;
#pragma unroll
            for (int q = 0; q < 16; ++q) s += red[(q * 8 + b) * 32 + cc];
            MOD[b * 6144 + j] = s + b_ada[j]; }
        __syncthreads();
    }
}
__device__ __forceinline__ int rowmap(int mode, int n) {
    if (mode == 1) return n < 3344 ? n : n + 240;
    if (mode == 2) { const int j = n < 2816 ? n : n - 2816; return (j >> 7) * 256 + (n < 2816 ? 0 : 128) + (j & 127); }
    return n;
}
__device__ __forceinline__ void tr_item(const float* W, int K, int N, bf16* WT, int ldt, int koff, int row_off, int mode, LAS float* scr, int item, int lane) {
    const int nblk = (N + 31) / 32, kb = item / nblk, nb = item % nblk, k0 = 64 * kb, n0 = 32 * nb;
    const int ncol = n0 + (lane & 31); const bool okc = ncol < N;
#pragma unroll 8
    for (int i = 0; i < 32; ++i) { const int kk = 2 * i + (lane >> 5); scr[kk * 33 + (lane & 31)] = okc ? W[(size_t)(k0 + kk) * N + ncol] : 0.f; }
    LDS_WAIT();
    const int c = lane & 7;
#pragma unroll
    for (int j = 0; j < 4; ++j) { const int n = (lane >> 3) + 8 * j; const LAS float* s = scr + (8 * c) * 33 + n;
        u4 o; o.x = pk2(s[0 * 33], s[1 * 33]); o.y = pk2(s[2 * 33], s[3 * 33]); o.z = pk2(s[4 * 33], s[5 * 33]); o.w = pk2(s[6 * 33], s[7 * 33]);
        if (n0 + n < N) *(u4*)(WT + (size_t)(rowmap(mode, n0 + n) + row_off) * ldt + koff + k0 + 8 * c) = o; }
    LDS_WAIT();
}
__device__ __forceinline__ void p0_weights(const Args& a, LAS float* ldsf) {
    const int tid = threadIdx.x, lane = tid & 63, wave = tid >> 6;
    LAS float* scr = ldsf + wave * 4096;
    const int gw = blockIdx.x * NWAVE + wave, NGW = gridDim.x * NWAVE;
    bf16* WinT = (bf16*)(a.ws + WS_WIN); bf16* W1T = (bf16*)(a.ws + WS_W1); bf16* W2T = (bf16*)(a.ws + WS_W2); bf16* WbrT = (bf16*)(a.ws + WS_WBR); bf16* WmixT = (bf16*)(a.ws + WS_WMIX);
    constexpr int I_IN = 16 * 169, I_F1 = 16 * 176, I_F2 = 44 * 32, I_BR = 8 * 32, I_MX = 16 * 32;
    constexpr int NITEMS = I_IN + I_F1 + I_F2 + 2 * I_BR + 2 * I_MX;
    for (int it = gw; it < NITEMS; it += NGW) {
        int r = it;
        if (r < I_IN) { tr_item(a.in[4], 1024, NIN, WinT, 1024, 0, 0, 1, scr, r, lane); continue; } r -= I_IN;
        if (r < I_F1) { tr_item(a.in[24], 1024, 2 * DFF, W1T, 1024, 0, 0, 2, scr, r, lane); continue; } r -= I_F1;
        if (r < I_F2) { tr_item(a.in[25], DFF, 1024, W2T, DFF, 0, 0, 0, scr, r, lane); continue; } r -= I_F2;
        if (r < I_BR) { tr_item(a.in[19], 512, 1024, WbrT, 512, 0, 0, 0, scr, r, lane); continue; } r -= I_BR;
        if (r < I_BR) { tr_item(a.in[20], 512, 1024, WbrT, 512, 0, 1024, 0, scr, r, lane); continue; } r -= I_BR;
        if (r < I_MX) { tr_item(a.in[21], 1024, 1024, WmixT, 2048, 0, 0, 0, scr, r, lane); continue; } r -= I_MX;
        tr_item(a.in[21], 1024, 1024, WmixT, 2048, 1024, 0, 0, scr, r, lane);
    }
    const u4 z = {0u, 0u, 0u, 0u};
    for (int i = blockIdx.x * NT + tid; i < 240 * 128; i += gridDim.x * NT) *((u4*)(WinT + (size_t)3344 * 1024) + i) = z;
}
__device__ __forceinline__ void p1_modulate(const float* x, const float* MOD, bf16* U) {
    const int tid = threadIdx.x, lane = tid & 63, wave = tid >> 6;
    const int gw = blockIdx.x * NWAVE + wave, NGW = gridDim.x * NWAVE;
    for (int m = gw; m < M; m += NGW) {
        const int b = m >> 11; const f4* xr = (const f4*)(x + (size_t)m * D) + lane;
        const f4* sh = (const f4*)(MOD + b * 6144) + lane; const f4* sc = (const f4*)(MOD + b * 6144 + 1024) + lane;
        u2* o = (u2*)(U + (size_t)m * D) + lane;
#pragma unroll
        for (int j = 0; j < 4; ++j) { const f4 v = xr[64 * j], s = sc[64 * j], h = sh[64 * j]; const f4 r = v * (s + 1.0f) + h;
            u2 w; w.x = pk2(r.x, r.y); w.y = pk2(r.z, r.w); o[64 * j] = w; }
    }
}
__device__ __forceinline__ void p3_lora(const Args& a, LAS float* ldsf) {
    const int tid = threadIdx.x;
    const bf16* RWP = (const bf16*)(a.ws + WS_RWP);
    const float* mu = a.in[5]; const float* w0 = a.in[6]; const float* w2 = a.in[7]; const float* a0 = a.in[8]; const float* a2 = a.in[9]; const float* g2 = a.in[10];
    float* E = a.out; bf16* A = (bf16*)(a.out + (size_t)8 * MiB); bf16* G = (bf16*)(a.out + (size_t)12 * MiB);
    float* INVN = (float*)(a.ws + WS_INVN); float* SB = (float*)(a.ws + WS_SB);
    constexpr int TS = 36;
    LAS float* TW = ldsf; LAS float* TA = ldsf + 64 * TS; LAS float* TG = ldsf + 128 * TS;
    for (int tile = blockIdx.x; tile < M / 32; tile += gridDim.x) {
        const int m0 = tile * 32;
        __syncthreads();
#pragma unroll 4
        for (int i = 0; i < 16; ++i) { const int e = tid + i * NT, tl = e >> 8, ci = e & 255, col = 1536 + ci, m = m0 + tl;
            const float p = bf2f(RWP[(size_t)m * RWC + col]); const float pp = (m & 2047) ? bf2f(RWP[(size_t)(m - 1) * RWC + col]) : 0.f;
            const float ps = p + mu[col] * (pp - p);
            float v; if (ci < 64) v = tanhf(ps); else if (ci < 128) v = ps; else v = sigm(ps);
            ldsf[ci * TS + tl] = v; }
        __syncthreads();
        const int j = tid;
        f4 acc[8];
#pragma unroll
        for (int q = 0; q < 8; ++q) acc[q] = (f4){0.f, 0.f, 0.f, 0.f};
#pragma unroll 4
        for (int kk = 0; kk < 64; ++kk) { const float w = w2[kk * 512 + j];
#pragma unroll
            for (int q = 0; q < 8; ++q) acc[q] += *(const LAS f4*)(TW + kk * TS + 4 * q) * w; }
        { const float wj = w0[j];
#pragma unroll
          for (int q = 0; q < 8; ++q)
#pragma unroll
            for (int i = 0; i < 4; ++i) E[(size_t)(m0 + 4 * q + i) * 512 + j] = 0.6065306597126334f * sigm(wj + acc[q][i]); }
#pragma unroll
        for (int q = 0; q < 8; ++q) acc[q] = (f4){0.f, 0.f, 0.f, 0.f};
#pragma unroll 4
        for (int kk = 0; kk < 64; ++kk) { const float w = a2[kk * 512 + j];
#pragma unroll
            for (int q = 0; q < 8; ++q) acc[q] += *(const LAS f4*)(TA + kk * TS + 4 * q) * w; }
        { const float aj = a0[j]; const float kkw = a.in[11][j], kaw = a.in[12][j], rkw = a.in[13][j], mu_r = mu[j], mu_k = mu[512 + j];
          const int hh = tid >> 6, ln = tid & 63;
#pragma unroll
          for (int q = 0; q < 8; ++q) {
            float rv_[5], kv_[5];
#pragma unroll
            for (int i = 0; i < 5; ++i) { const int m = m0 + 4 * q + i - 1; const bool ok = (i > 0) || ((m + 1) & 2047); const size_t mm = ok ? (size_t)m : (size_t)(m + 1);
                rv_[i] = bf2f(RWP[mm * RWC + j]); kv_[i] = bf2f(RWP[mm * RWC + 512 + j]); if (!ok) { rv_[i] = 0.f; kv_[i] = 0.f; } }
#pragma unroll
            for (int i = 0; i < 4; ++i) { const int m = m0 + 4 * q + i; const float av = sigm(aj + acc[q][i]);
                A[(size_t)m * 512 + j] = (bf16)f2bf(av);
                const float r = rv_[i + 1] + mu_r * (rv_[i] - rv_[i + 1]), k = kv_[i + 1] + mu_k * (kv_[i] - kv_[i + 1]);
                const float kkv = k * kkw; float n2 = reduce16(kkv * kkv); n2 += __shfl_xor(n2, 16); n2 += __shfl_xor(n2, 32);
                const float k2 = k * (1.f + (av - 1.f) * kaw); float sb = reduce16(r * k2 * rkw); sb += __shfl_xor(sb, 16); sb += __shfl_xor(sb, 32);
                if (ln == 0) { INVN[(size_t)m * 8 + hh] = 1.f / fmaxf(sqrtf(n2), 1e-12f); SB[(size_t)m * 8 + hh] = sb; } } } }
#pragma unroll
        for (int q = 0; q < 8; ++q) acc[q] = (f4){0.f, 0.f, 0.f, 0.f};
#pragma unroll 4
        for (int kk = 0; kk < 128; ++kk) { const float w = g2[kk * 512 + j];
#pragma unroll
            for (int q = 0; q < 8; ++q) acc[q] += *(const LAS f4*)(TG + kk * TS + 4 * q) * w; }
#pragma unroll
        for (int q = 0; q < 8; ++q)
#pragma unroll
            for (int i = 0; i < 4; ++i) G[(size_t)(m0 + 4 * q + i) * 512 + j] = (bf16)f2bf(acc[q][i]);
    }
}
__device__ __forceinline__ void gla_pre(const Args& a, LAS float* ldsf) {
    const int tid = threadIdx.x, dd = tid & 63, tg = tid >> 6;
    bf16* GLAP = (bf16*)(a.ws + WS_GLAP); bf16* KDT = (bf16*)(a.ws + WS_KDT); float* DECG = (float*)(a.ws + WS_DECG);
    const float* ga2 = a.in[16]; const float* gab = a.in[17];
    LAS float* AD = ldsf; LAS float* GT = ldsf + 1024;
    for (int u = blockIdx.x; u < 1024; u += gridDim.x) {
        const int bh = u >> 5, c = u & 31, b = bh >> 2, h = bh & 3; const size_t m0 = (size_t)b * SEQ + (size_t)c * 64;
        float a2r[16];
#pragma unroll
        for (int j = 0; j < 16; ++j) a2r[j] = ga2[j * 256 + h * 64 + dd];
        const float abr = gab[h * 64 + dd];
        float qv[8], kv[8];
#pragma unroll
        for (int i = 0; i < 8; ++i) { const bf16* p = GLAP + (m0 + tg * 8 + i) * GLCP + h * 64 + dd; qv[i] = bf2f(p[0]); kv[i] = bf2f(p[256]); }
        __syncthreads();
#pragma unroll
        for (int i = 0; i < 2; ++i) { const int e = tid + NT * i, t = e >> 4, j = e & 15; AD[e] = bf2f(GLAP[(m0 + t) * GLCP + 1536 + j]); }
        __syncthreads();
        float bl[8]; float run = 0.f;
#pragma unroll
        for (int i = 0; i < 8; ++i) { const int t = tg * 8 + i; float z = abr;
#pragma unroll
            for (int j4 = 0; j4 < 4; ++j4) { const f4 av = *(const LAS f4*)(AD + t * 16 + 4 * j4); z += av.x * a2r[4 * j4] + av.y * a2r[4 * j4 + 1] + av.z * a2r[4 * j4 + 2] + av.w * a2r[4 * j4 + 3]; }
            const float ls = fminf(z, 0.f) - __logf(1.f + __expf(-fabsf(z)));
            run += ls * 0.0625f; bl[i] = run; }
        GT[tg * 64 + dd] = run;
        __syncthreads();
        float off = 0.f, tot = 0.f;
#pragma unroll
        for (int g = 0; g < 8; ++g) { const float gv = GT[g * 64 + dd]; off += (g < tg) ? gv : 0.f; tot += gv; }
        unsigned kd[4];
#pragma unroll
        for (int i = 0; i < 8; ++i) { const float bc = bl[i] + off; bf16* p = GLAP + (m0 + tg * 8 + i) * GLCP + h * 64 + dd;
            p[0] = (bf16)f2bf(qv[i] * 0.125f * __expf(bc)); p[256] = (bf16)f2bf(kv[i] * __expf(-bc));
            const unsigned kdb = f2bf(kv[i] * __expf(tot - bc)); if (i & 1) kd[i >> 1] |= kdb << 16; else kd[i >> 1] = kdb; }
        *(u4*)(KDT + ((size_t)u * 64 + dd) * 64 + tg * 8) = (u4){kd[0], kd[1], kd[2], kd[3]};
        if (tg == 0) DECG[u * 64 + dd] = __expf(tot);
    }
}
__device__ __forceinline__ void rw_scan_unit(const Args& a, LAS float* ldsf, int unit) {
    const int tid = threadIdx.x, lane = tid & 63, wave = tid >> 6;
    const int bh = unit >> 2, qr = unit & 3, b = bh >> 3, h = bh & 7;
    const bf16* RWP = (const bf16*)(a.ws + WS_RWP);
    const float* E = a.out; const bf16* A = (const bf16*)(a.out + (size_t)8 * MiB);
    bf16* Yraw = (bf16*)(a.ws + WS_U);
    const float* mu = a.in[5];
    const int col = h * 64 + lane;
    const float mu_r = mu[col], mu_k = mu[512 + col], mu_v = mu[1024 + col];
    const float kkw = a.in[11][col], kaw = a.in[12][col];
    constexpr int BUF = 6 * 2048, NCH = 64 * REP_RW;
    LAS float* Ybuf = ldsf + 2 * BUF;
    const int rowl = (tid >> 4) & 15, kq = tid & 15;
    const size_t mb = (size_t)b * SEQ;
    const int pw = wave & 3;
    unsigned short rrA[9], rkA[9], rvA[9], raA[8]; float reA[8], rnA[8];
    unsigned short rrB[9], rkB[9], rvB[9], raB[8]; float reB[8], rnB[8];
    const float* INVN = (const float*)(a.ws + WS_INVN);
#define RW_LOAD(c, S) do { const int t0 = (c) * 32 + 8 * pw; const bf16* p = RWP + (mb + t0) * RWC + col; const bf16* q = t0 ? p - RWC : p; rr##S[0] = q[0]; rk##S[0] = q[512]; rv##S[0] = q[1024]; \
        _Pragma("unroll") for (int i = 0; i < 8; ++i) { rr##S[i + 1] = p[(size_t)i * RWC]; rk##S[i + 1] = p[(size_t)i * RWC + 512]; rv##S[i + 1] = p[(size_t)i * RWC + 1024]; \
            re##S[i] = E[(mb + t0 + i) * 512 + col]; ra##S[i] = A[(mb + t0 + i) * 512 + col]; rn##S[i] = INVN[(mb + t0 + i) * 8 + h]; } } while (0)
#define RW_FINAL(c, buf, S) do { LAS float* B_ = ldsf + (buf) * BUF; const int t0 = (c) * 32 + 8 * pw; _Pragma("unroll") for (int i = 0; i < 8; ++i) { const int tl = 8 * pw + i; \
        const float rp = bf2f(rr##S[i + 1]), kp = bf2f(rk##S[i + 1]), vp = bf2f(rv##S[i + 1]); const bool has = (t0 + i) != 0; \
        const float rq = has ? bf2f(rr##S[i]) : 0.f, kq_ = has ? bf2f(rk##S[i]) : 0.f, vq = has ? bf2f(rv##S[i]) : 0.f; \
        const float r = rp + mu_r * (rq - rp), k = kp + mu_k * (kq_ - kp), v = vp + mu_v * (vq - vp); \
        const float av = bf2f(ra##S[i]); const float dec = __expf(-re##S[i]); \
        const float kkn = k * kkw * rn##S[i]; const float k2 = k * (1.f + (av - 1.f) * kaw); const float bb = kkn * av; \
        B_[0 * 2048 + tl * 64 + lane] = r; B_[1 * 2048 + tl * 64 + lane] = dec; B_[2 * 2048 + tl * 64 + lane] = k2; \
        B_[3 * 2048 + tl * 64 + lane] = v; B_[4 * 2048 + tl * 64 + lane] = -kkn; B_[5 * 2048 + tl * 64 + lane] = bb; } } while (0)
#define RW_YOUT(c) do { const LAS float* Y_ = Ybuf + ((c) & 1) * 512; const int e = (tid - 256) * 2, tl = e >> 4, rl = e & 15; const f2 yv = *(const LAS f2*)(Y_ + e); \
        *(unsigned*)(Yraw + (mb + (size_t)(c) * 32 + tl) * 512 + h * 64 + qr * 16 + rl) = pk2(yv.x, yv.y); } while (0)
#define RW_CONSUME(cc) RW_CONSUME_(cc, 0, sA, sB)
#define RW_OPS(P_, tl_) P_##r4 = *(const LAS f4*)(Bc + 0 * 2048 + (tl_) * 64); P_##w4 = *(const LAS f4*)(Bc + 1 * 2048 + (tl_) * 64); P_##k4 = *(const LAS f4*)(Bc + 2 * 2048 + (tl_) * 64); \
                         P_##n4 = *(const LAS f4*)(Bc + 4 * 2048 + (tl_) * 64); P_##b4 = *(const LAS f4*)(Bc + 5 * 2048 + (tl_) * 64); P_##v1 = Vc[(tl_) * 64];
#define RW_UPDATE(sa_) do { const f2 vkA = (f2){c_k4.x, c_k4.y} * c_v1, vkB = (f2){c_k4.z, c_k4.w} * c_v1; const f2 sa2 = {sa_, sa_}; \
                const f2 tA = __builtin_elementwise_fma(sa2, (f2){c_b4.x, c_b4.y}, vkA), tB = __builtin_elementwise_fma(sa2, (f2){c_b4.z, c_b4.w}, vkB); \
                sA = __builtin_elementwise_fma(sA, (f2){c_w4.x, c_w4.y}, tA); sB = __builtin_elementwise_fma(sB, (f2){c_w4.z, c_w4.w}, tB); } while (0)
#define RW_CONSUME_(cc, YOFF, sA, sB) do { \
            const LAS float* Bc = ldsf + ((cc) & 1) * BUF + 4 * kq; \
            LAS float* Yw = (kq == 0) ? (Ybuf + (YOFF) + ((cc) & 1) * 512 + rowl) : (Ybuf + 2048 + tid); const int ystr = (kq == 0) ? 16 : 0; \
            const LAS float* Vc = ldsf + ((cc) & 1) * BUF + 3 * 2048 + qr * 16 + rowl; \
            f4 rprev, c_r4, c_w4, c_k4, c_n4, c_b4, x_r4, x_w4, x_k4, x_n4, x_b4; float c_v1, x_v1; \
            RW_OPS(c_, 0) RW_OPS(x_, 1) \
            { f2 pp = sA * (f2){c_n4.x, c_n4.y}; pp = __builtin_elementwise_fma(sB, (f2){c_n4.z, c_n4.w}, pp); const float sa = reduce16(pp.x + pp.y); RW_UPDATE(sa); rprev = c_r4; } \
            _Pragma("unroll 2") for (int tl = 1; tl < 32; ++tl) { \
                c_r4 = x_r4; c_w4 = x_w4; c_k4 = x_k4; c_n4 = x_n4; c_b4 = x_b4; c_v1 = x_v1; \
                RW_OPS(x_, (tl + 1) & 31) \
                f2 pp = sA * (f2){c_n4.x, c_n4.y}; f2 yy = sA * (f2){rprev.x, rprev.y}; \
                pp = __builtin_elementwise_fma(sB, (f2){c_n4.z, c_n4.w}, pp); yy = __builtin_elementwise_fma(sB, (f2){rprev.z, rprev.w}, yy); \
                float p = pp.x + pp.y, y = yy.x + yy.y; \
                p += dppf<0xB1>(p); y += dppf<0xB1>(y); p += dppf<0x4E>(p); y += dppf<0x4E>(y); p += dppf<0x141>(p); y += dppf<0x141>(y); p += dppf<0x128>(p); y += dppf<0x128>(y); \
                Yw[(tl - 1) * ystr] = y; \
                RW_UPDATE(p); rprev = c_r4; } \
            { f2 yy = sA * (f2){rprev.x, rprev.y}; yy = __builtin_elementwise_fma(sB, (f2){rprev.z, rprev.w}, yy); const float y = reduce16(yy.x + yy.y); Yw[31 * ystr] = y; } } while (0)
#define RW_PRODUCE(cc, SL, SF) do { if ((cc) > 0) RW_YOUT(((cc) - 1) & 63); if ((cc) + 1 < NCH) { RW_LOAD(((cc) + 2) & 63, SL); RW_FINAL(((cc) + 1) & 63, ((cc) + 1) & 1, SF); } } while (0)
#ifndef REP_CONS
#define REP_CONS 1
#endif
#ifndef REP_PROD
#define REP_PROD 1
#endif
#define RW_CONS2(cc) do { if (REP_CONS > 1) { const f2 sA0 = sA, sB0 = sB; RW_CONSUME(cc); sA = sA0; sB = sB0; } RW_CONSUME(cc); } while (0)
#define RW_PROD2(cc, SF) do { if (REP_PROD > 1 && (cc) + 1 < NCH) { RW_FINAL(((cc) + 1) & 63, ((cc) + 1) & 1, SF); } } while (0)
    __syncthreads();
    if (wave >= 4) { RW_LOAD(0, A); RW_LOAD(1, B); RW_FINAL(0, 0, A); }
    __syncthreads();
#ifndef DUP_CONS
#define DUP_CONS 0
#endif
    f2 sA = {0.f, 0.f}, sB = {0.f, 0.f}; f2 dA = {0.f, 0.f}, dB = {0.f, 0.f};
    for (int cc_ = 0; cc_ < NCH; cc_ += 2) {
        if (wave < 4) { if (REP_RW > 1 && (cc_ & 63) == 0) { sA = (f2){0.f, 0.f}; sB = (f2){0.f, 0.f}; } RW_CONS2(cc_); } else { RW_PRODUCE(cc_, A, B); RW_PROD2(cc_, B); if (DUP_CONS) RW_CONSUME_(cc_, 1024, dA, dB); }
        __syncthreads();
        if (wave < 4) { RW_CONS2(cc_ + 1); } else { RW_PRODUCE(cc_ + 1, B, A); RW_PROD2(cc_ + 1, A); if (DUP_CONS) RW_CONSUME_(cc_ + 1, 1024, dA, dB); }
        __syncthreads();
    }
    if (wave >= 4) RW_YOUT((NCH - 1) & 63);
#undef RW_LOAD
#undef RW_FINAL
#undef RW_YOUT
#undef RW_CONSUME
#undef RW_CONSUME_
#undef RW_OPS
#undef RW_UPDATE
#undef RW_PRODUCE
}
__device__ __forceinline__ void gla_unit(const Args& a, LAS unsigned char* L, int unit) {
    typedef short bf16x8 __attribute__((ext_vector_type(8)));
    const int tid = threadIdx.x, lane = tid & 63, wave = tid >> 6, fr = lane & 15, fq = lane >> 4;
    const int bh = unit >> 3, vs = unit & 7, b = bh >> 2, h = bh & 3;
    const bf16* GLAP = (const bf16*)(a.ws + WS_GLAP); bf16* Oraw = (bf16*)(a.ws + WS_U + 16 * MiB);
    const bf16* KDT = (const bf16*)(a.ws + WS_KDT); const float* DECG = (const float*)(a.ws + WS_DECG);
    constexpr int P = 72;
    LAS bf16* Qs = (LAS bf16*)L; LAS bf16* Ks = Qs + 64 * P; LAS bf16* Kdt = Ks + 64 * P; LAS bf16* Att = Kdt + 64 * P;
    LAS bf16* Vt = Att + 64 * P; LAS bf16* St = Vt + 16 * P;
    LAS float* DEC = (LAS float*)(St + 2 * 16 * P);
    const size_t mb = (size_t)b * SEQ;
    constexpr int NCH = 32 * REP_GLA;
    const int lt = tid >> 3, lp = tid & 7;
    u4 pq, pk, pd, pv; float pdec;
#define GLA_LOAD(c) do { const size_t m0 = mb + (size_t)(c) * 64; const bf16* p = GLAP + (m0 + lt) * GLCP + h * 64 + lp * 8; pq = *(const u4*)p; pk = *(const u4*)(p + 256); \
        const int uc = bh * 32 + (c); pd = *(const u4*)(KDT + ((size_t)uc * 64 + lt) * 64 + lp * 8); \
        if (tid < 128) pv = *(const u4*)(GLAP + (m0 + (tid >> 1)) * GLCP + 512 + h * 128 + vs * 16 + (tid & 1) * 8); \
        if (tid < 64) pdec = DECG[uc * 64 + tid]; } while (0)
#define GLA_STORE() do { *(LAS u4*)(Qs + lt * P + lp * 8) = pq; *(LAS u4*)(Ks + lt * P + lp * 8) = pk; *(LAS u4*)(Kdt + lt * P + lp * 8) = pd; \
        if (tid < 128) { const int t = tid >> 1, v0 = (tid & 1) * 8; Vt[(v0 + 0) * P + t] = (bf16)(pv.x & 0xffffu); Vt[(v0 + 1) * P + t] = (bf16)(pv.x >> 16); Vt[(v0 + 2) * P + t] = (bf16)(pv.y & 0xffffu); Vt[(v0 + 3) * P + t] = (bf16)(pv.y >> 16); \
            Vt[(v0 + 4) * P + t] = (bf16)(pv.z & 0xffffu); Vt[(v0 + 5) * P + t] = (bf16)(pv.z >> 16); Vt[(v0 + 6) * P + t] = (bf16)(pv.w & 0xffffu); Vt[(v0 + 7) * P + t] = (bf16)(pv.w >> 16); } \
        if (tid < 64) DEC[tid] = pdec; } while (0)
    __syncthreads();
    for (int i = tid; i < 2 * 16 * P; i += NT) St[i] = 0;
    GLA_LOAD(0); GLA_STORE();
    pg8::f32x4 Sacc = {0.f, 0.f, 0.f, 0.f};
    __syncthreads();
    for (int cc_ = 0; cc_ < NCH; ++cc_) {
        const int c = cc_ & 31;
        if (REP_GLA > 1 && c == 0 && cc_ > 0) { Sacc = (pg8::f32x4){0.f, 0.f, 0.f, 0.f}; for (int i = tid; i < 2 * 16 * P; i += NT) St[i] = 0; __syncthreads(); }
        if (cc_ + 1 < NCH) GLA_LOAD((cc_ + 1) & 31);
        { const int mt = wave >> 1;
          const bf16x8 qa0 = *(const LAS bf16x8*)(Qs + (16 * mt + fr) * P + fq * 8), qa1 = *(const LAS bf16x8*)(Qs + (16 * mt + fr) * P + 32 + fq * 8);
#pragma unroll
          for (int u = 0; u < 2; ++u) { const int nt = 2 * (wave & 1) + u; pg8::f32x4 acc = {0.f, 0.f, 0.f, 0.f};
            if (nt <= mt) { const bf16x8 kb0 = *(const LAS bf16x8*)(Ks + (16 * nt + fr) * P + fq * 8), kb1 = *(const LAS bf16x8*)(Ks + (16 * nt + fr) * P + 32 + fq * 8);
                acc = __builtin_amdgcn_mfma_f32_16x16x32_bf16(qa0, kb0, acc, 0, 0, 0); acc = __builtin_amdgcn_mfma_f32_16x16x32_bf16(qa1, kb1, acc, 0, 0, 0); }
#pragma unroll
            for (int j = 0; j < 4; ++j) { const bool keep = (nt < mt) || (nt == mt && fr <= fq * 4 + j); Att[(16 * mt + fq * 4 + j) * P + 16 * nt + fr] = (bf16)f2bf(keep ? acc[j] : 0.f); } } }
        __syncthreads();
        { const LAS bf16* Sc = St + (cc_ & 1) * 16 * P; LAS bf16* Sn = St + ((cc_ + 1) & 1) * 16 * P;
          const bf16x8 vb0 = *(const LAS bf16x8*)(Vt + fr * P + fq * 8), vb1 = *(const LAS bf16x8*)(Vt + fr * P + 32 + fq * 8);
          if (wave < 4) { const int mt = wave; pg8::f32x4 acc = {0.f, 0.f, 0.f, 0.f};
            const bf16x8 aa0 = *(const LAS bf16x8*)(Att + (16 * mt + fr) * P + fq * 8), aa1 = *(const LAS bf16x8*)(Att + (16 * mt + fr) * P + 32 + fq * 8);
            const bf16x8 qa0 = *(const LAS bf16x8*)(Qs + (16 * mt + fr) * P + fq * 8), qa1 = *(const LAS bf16x8*)(Qs + (16 * mt + fr) * P + 32 + fq * 8);
            const bf16x8 sb0 = *(const LAS bf16x8*)(Sc + fr * P + fq * 8), sb1 = *(const LAS bf16x8*)(Sc + fr * P + 32 + fq * 8);
            acc = __builtin_amdgcn_mfma_f32_16x16x32_bf16(aa0, vb0, acc, 0, 0, 0); acc = __builtin_amdgcn_mfma_f32_16x16x32_bf16(aa1, vb1, acc, 0, 0, 0);
            acc = __builtin_amdgcn_mfma_f32_16x16x32_bf16(qa0, sb0, acc, 0, 0, 0); acc = __builtin_amdgcn_mfma_f32_16x16x32_bf16(qa1, sb1, acc, 0, 0, 0);
#pragma unroll
            for (int j = 0; j < 4; ++j) Oraw[(mb + (size_t)c * 64 + 16 * mt + fq * 4 + j) * 512 + h * 128 + vs * 16 + fr] = (bf16)f2bf(acc[j]);
          } else { const int dt = wave - 4;
            const bf16x8 ka0 = *(const LAS bf16x8*)(Kdt + (16 * dt + fr) * P + fq * 8), ka1 = *(const LAS bf16x8*)(Kdt + (16 * dt + fr) * P + 32 + fq * 8);
            const f4 dc = *(const LAS f4*)(DEC + 16 * dt + fq * 4);
            Sacc[0] *= dc.x; Sacc[1] *= dc.y; Sacc[2] *= dc.z; Sacc[3] *= dc.w;
            Sacc = __builtin_amdgcn_mfma_f32_16x16x32_bf16(ka0, vb0, Sacc, 0, 0, 0); Sacc = __builtin_amdgcn_mfma_f32_16x16x32_bf16(ka1, vb1, Sacc, 0, 0, 0);
            *(LAS u2*)(Sn + fr * P + 16 * dt + fq * 4) = (u2){pk2(Sacc[0], Sacc[1]), pk2(Sacc[2], Sacc[3])}; } }
        __syncthreads();
        if (cc_ + 1 < NCH) GLA_STORE();
        __syncthreads();
    }
#undef GLA_LOAD
#undef GLA_STORE
}
__device__ __forceinline__ void p5_post(const Args& a) {
    const int tid = threadIdx.x, lane = tid & 63, wave = tid >> 6;
    const int gw = blockIdx.x * NWAVE + wave, NGW = gridDim.x * NWAVE;
    const bf16* RWP = (const bf16*)(a.ws + WS_RWP); const bf16* GLAP = (const bf16*)(a.ws + WS_GLAP);
    bf16* Yraw = (bf16*)(a.ws + WS_U); bf16* Oraw = (bf16*)(a.ws + WS_U + 16 * MiB);
    const bf16* G = (const bf16*)(a.out + (size_t)12 * MiB); const float* SB = (const float*)(a.ws + WS_SB);
    const float* mu = a.in[5]; const float* gng = a.in[14]; const float* gnb = a.in[15]; const float* nrm = a.in[18];
    const float ng0 = nrm[lane], ng1 = nrm[64 + lane];
    for (int m = gw; m < M; m += NGW) {
        const int t = m & 2047;
#pragma unroll
        for (int h = 0; h < 8; ++h) { const int col = h * 64 + lane;
            const float y = bf2f(Yraw[(size_t)m * 512 + col]);
            const float vp = bf2f(RWP[(size_t)m * RWC + 1024 + col]); const float vq = t ? bf2f(RWP[(size_t)(m - 1) * RWC + 1024 + col]) : 0.f;
            const float v = vp + mu[1024 + col] * (vq - vp);
            const float g = bf2f(G[(size_t)m * 512 + col]); const float sb = SB[(size_t)m * 8 + h];
            const float mean = wave_sum(y) * (1.f / 64.f); const float dl = y - mean; const float var = wave_sum(dl * dl) * (1.f / 64.f);
            const float yn = dl * rsqrtf(var + GN_EPS) * gng[col] + gnb[col];
            Yraw[(size_t)m * 512 + col] = (bf16)f2bf((yn + sb * v) * g); }
#pragma unroll
        for (int h = 0; h < 4; ++h) { const int c0 = h * 128 + lane, c1 = c0 + 64;
            const float o0 = bf2f(Oraw[(size_t)m * 512 + c0]), o1 = bf2f(Oraw[(size_t)m * 512 + c1]);
            const float g0 = bf2f(GLAP[(size_t)m * GLCP + 1024 + c0]), g1 = bf2f(GLAP[(size_t)m * GLCP + 1024 + c1]);
            const float ms = wave_sum(o0 * o0 + o1 * o1) * (1.f / 128.f); const float rs = rsqrtf(ms + GLA_EPS);
            Oraw[(size_t)m * 512 + c0] = (bf16)f2bf(o0 * rs * ng0 * g0 * sigm(g0)); Oraw[(size_t)m * 512 + c1] = (bf16)f2bf(o1 * rs * ng1 * g1 * sigm(g1)); }
    }
}
__device__ __forceinline__ void ln_rows(float* X, const float* g, const float* bta, const float* MOD, bf16* U2) {
    const int tid = threadIdx.x, lane = tid & 63, wave = tid >> 6;
    const int gw = blockIdx.x * NWAVE + wave, NGW = gridDim.x * NWAVE;
    for (int m = gw; m < M; m += NGW) {
        f4* xr = (f4*)(X + (size_t)m * D) + lane; f4 v[4]; float s = 0.f;
#pragma unroll
        for (int j = 0; j < 4; ++j) { v[j] = xr[64 * j]; s += (v[j].x + v[j].y) + (v[j].z + v[j].w); }
        const float mean = wave_sum(s) * (1.f / D); float s2 = 0.f;
#pragma unroll
        for (int j = 0; j < 4; ++j) { v[j] = v[j] - mean; s2 += (v[j].x * v[j].x + v[j].y * v[j].y) + (v[j].z * v[j].z + v[j].w * v[j].w); }
        const float rstd = rsqrtf(wave_sum(s2) * (1.f / D) + LN_EPS);
        const int b = m >> 11;
#pragma unroll
        for (int j = 0; j < 4; ++j) { const f4 gg = ((const f4*)g)[lane + 64 * j], bb = ((const f4*)bta)[lane + 64 * j]; const f4 r = v[j] * rstd * gg + bb; xr[64 * j] = r;
            if (U2) { const f4 sh = ((const f4*)(MOD + b * 6144 + 3072))[lane + 64 * j], sc = ((const f4*)(MOD + b * 6144 + 4096))[lane + 64 * j]; const f4 uu = r * (sc + 1.0f) + sh;
                u2 w; w.x = pk2(uu.x, uu.y); w.y = pk2(uu.z, uu.w); ((u2*)(U2 + (size_t)m * D))[lane + 64 * j] = w; } }
    }
}

#ifndef REPMASK
#define REPMASK 0
#endif
#define PH_BEGIN(k) _Pragma("unroll") for (int rep_ = 0; rep_ < 1 + ((REPMASK >> (k)) & 1); ++rep_) {
#define PH_END() grid.sync(); }
__global__ void __launch_bounds__(NT, 2) fwd_mega(Args a) {
    extern __shared__ __attribute__((aligned(16))) unsigned char lds[];
    cg::grid_group grid = cg::this_grid();
    LAS unsigned char* L = (LAS unsigned char*)lds; LAS float* ldsf = (LAS float*)lds;
    unsigned char* ws = a.ws;
    float* MOD = (float*)(ws + WS_MOD);
    bf16* U = (bf16*)(ws + WS_U);
    const int G = gridDim.x;
    PH_BEGIN(0)
    p0_mod(a.in[1], a.in[2], a.in[3], MOD, ldsf);
    p0_weights(a, ldsf);
    PH_END()
    PH_BEGIN(1)
    p1_modulate(a.in[0], MOD, U);
    PH_END()
    PH_BEGIN(2)
    { pg8::Gemm g{U, (const bf16*)(ws + WS_WIN), M, NPROJ, D, U, 1 << 30}; pg8::StaticOrder S; S.init(M, NPROJ, G, (int)blockIdx.x);
      EpiProj E{(bf16*)(ws + WS_RWP), (bf16*)(ws + WS_GLAP), (bf16*)(ws + WS_GATES)};
      pg8::gemm_phase<EpiProj, pg8::StaticOrder, true, true>(L, g, S, E); }
    PH_END()
    PH_BEGIN(3)
    p3_lora(a, ldsf);
    gla_pre(a, ldsf);
    PH_END()
    PH_BEGIN(4)
    for (int unit = blockIdx.x; unit < 256; unit += G) rw_scan_unit(a, ldsf, unit);
    __syncthreads();
    for (int unit = blockIdx.x; unit < 256; unit += G) gla_unit(a, L, unit);
    PH_END()
    PH_BEGIN(5)
    p5_post(a);
    PH_END()
    PH_BEGIN(6)
    { pg8::Gemm g{U, (const bf16*)(ws + WS_WBR), M, 2048, 512, (const bf16*)(ws + WS_U + 16 * MiB), 4}; pg8::StaticOrder S; S.init(M, 2048, G, (int)blockIdx.x);
      EpiGate E{(bf16*)(ws + WS_MG), (const bf16*)(ws + WS_GATES)};
      pg8::gemm_phase<EpiGate, pg8::StaticOrder, true, true>(L, g, S, E); }
    PH_END()
    PH_BEGIN(7)
    { pg8::Gemm g{(const bf16*)(ws + WS_MG), (const bf16*)(ws + WS_WMIX), M, D, 2048, (const bf16*)(ws + WS_MG), 1 << 30}; pg8::StaticOrder S; S.init(M, D, G, (int)blockIdx.x);
      EpiRes E{a.in[0], a.out, MOD + 2048};
      pg8::gemm_phase<EpiRes, pg8::StaticOrder, true, true>(L, g, S, E); }
    PH_END()
    PH_BEGIN(8)
    ln_rows(a.out, a.in[22], a.in[23], MOD, U);
    PH_END()
    PH_BEGIN(9)
    { pg8::Gemm g{U, (const bf16*)(ws + WS_W1), M, 2 * DFF, D, U, 1 << 30}; pg8::StaticOrder S; S.init(M, 2 * DFF, G, (int)blockIdx.x);
      EpiSwiGLU E{(bf16*)(ws + WS_H)};
      pg8::gemm_phase<EpiSwiGLU, pg8::StaticOrder, true, true>(L, g, S, E); }
    PH_END()
    PH_BEGIN(10)
    { pg8::Gemm g{(const bf16*)(ws + WS_H), (const bf16*)(ws + WS_W2), M, D, DFF, (const bf16*)(ws + WS_H), 1 << 30}; pg8::StaticOrder S; S.init(M, D, G, (int)blockIdx.x);
      EpiRes E{a.out, a.out, MOD + 5120};
      pg8::gemm_phase<EpiRes, pg8::StaticOrder, true, true>(L, g, S, E); }
    PH_END()
    PH_BEGIN(11)
    ln_rows(a.out, a.in[26], a.in[27], MOD, nullptr);
    }
}

extern "C" void kernel_launch(void* const* d_in, const int* in_sizes, int n_in, void* d_out, int out_size, void* d_ws, size_t ws_size, hipStream_t stream) {
    static int grid = 0;
    if (grid == 0) {
        int dev = 0, cus = 0, per_cu = 0;
        hipGetDevice(&dev);
        hipDeviceGetAttribute(&cus, hipDeviceAttributeMultiprocessorCount, dev);
        if (hipFuncSetAttribute((const void*)fwd_mega, hipFuncAttributeMaxDynamicSharedMemorySize, LDS_BYTES) != hipSuccess) fprintf(stderr, "hipFuncSetAttribute failed\n");
        if (hipOccupancyMaxActiveBlocksPerMultiprocessor(&per_cu, (const void*)fwd_mega, NT, LDS_BYTES) != hipSuccess || per_cu < 1) { fprintf(stderr, "occupancy query: %d\n", per_cu); per_cu = 1; }
        (void)hipGetLastError();
        grid = cus * 1;
        if (grid <= 0) grid = 256;
    }
    Args a{};
    for (int i = 0; i < 28; ++i) a.in[i] = (const float*)d_in[i];
    a.out = (float*)d_out; a.ws = (unsigned char*)d_ws;
    void* args[] = {&a};
    hipError_t e = hipLaunchCooperativeKernel((const void*)fwd_mega, dim3(grid), dim3(NT), args, LDS_BYTES, stream);
    if (e != hipSuccess) fprintf(stderr, "cooperative launch failed: %s (grid %d)\n", hipGetErrorString(e), grid);
}
```

```cpp
#include <hip/hip_runtime.h>
#include <hip/hip_cooperative_groups.h>
#include <cstdio>
#include <cstdint>
namespace cg = cooperative_groups;
namespace pg8 {
#define PG8_LAS __attribute__((address_space(3)))
typedef unsigned short bf16_t;
typedef short bf16x8 __attribute__((ext_vector_type(8)));
typedef float f32x4 __attribute__((ext_vector_type(4)));
typedef unsigned u32x4 __attribute__((ext_vector_type(4)));
constexpr int BM = 256, BK = 64, HALF = 128, HTB = HALF * BK * 2  , STAGE_BYTES = 8 * HTB, NXCD = 8, WGM = 8;

__host__ __device__ __forceinline__ int lds_byte(int r, int c) { const int st = (r >> 4) * 2 + (c >> 5), rr = r & 15, cc = c & 31, ob = rr * 64 + cc * 2; return st * 1024 + (ob ^ (((ob >> 9) & 1) << 5)); }
__host__ __device__ __forceinline__ void stage_rc(int b, int& R, int& C) { const int st = b / 1024, sb = b % 1024, swz = sb ^ (((sb >> 9) & 1) << 5); R = (st >> 1) * 16 + swz / 64; C = (st & 1) * 32 + (swz % 64) / 2; }
__host__ __device__ __forceinline__ int perm32(int rho) { const int n = rho >> 4, i = rho & 15; return 8 * (i >> 2) + 4 * n + (i & 3); }

struct Unit { int pm, pn, part; };
struct Gemm { const bf16_t* A; const bf16_t* Bt; int M, N, K; const bf16_t* A2; int bpart; };

struct StaticOrder {
    int nM, nN, nwg, G, c;
    __host__ __device__ void init(int M, int N, int G_, int c_) { nM = M / BM; nN = N / BM; nwg = nM * nN; G = G_; c = c_; }
    __host__ __device__ bool next(int i, Unit& u) const {
        const long L = (long)i * G + c; if (L >= nwg) return false;
        int wgid = (int)L; { const int q = nwg / NXCD, r = nwg % NXCD, xcd = wgid % NXCD, off = wgid / NXCD; wgid = (xcd < r ? xcd * (q + 1) : r * (q + 1) + (xcd - r) * q) + off; }
        const int nig = WGM * nN, gid = wgid / nig, fm = gid * WGM, gsz = (nM - fm) < WGM ? (nM - fm) : WGM;
        u.pm = fm + ((wgid % nig) % gsz); u.pn = (wgid % nig) / gsz; u.part = 0; return true;
    }
    __device__ __forceinline__ void a_ready(const Unit&) const {}
    __device__ __forceinline__ void done(const Unit&) const {}
};

struct TwoPartOrder {
    StaticOrder S;
    __host__ __device__ void init(int M, int N, int G_, int c_) { S.init(M, N, G_, c_); }
    __host__ __device__ bool next(int i, Unit& u) const { if (!S.next(i >> 1, u)) return false; u.part = i & 1; return true; }
    __device__ __forceinline__ void a_ready(const Unit&) const {}
    __device__ __forceinline__ void done(const Unit&) const {}
};
__device__ __forceinline__ unsigned cvt_pk_bf16(float lo, float hi) { unsigned r; asm volatile("v_cvt_pk_bf16_f32 %0, %1, %2" : "=v"(r) : "v"(lo), "v"(hi)); return r; }
typedef float f32x2 __attribute__((ext_vector_type(2)));
template <class Epi, class Sched, bool ALIGN_EPI = false, bool SP2 = false>
__device__ __forceinline__ void gemm_phase(PG8_LAS unsigned char* lds, const Gemm g, const Sched& S, const Epi& E) {
    const int tid = threadIdx.x, wid = __builtin_amdgcn_readfirstlane(tid >> 6), lane = tid & 63, wr = wid >> 2, wc = wid & 3, fr = lane & 15, fq = lane >> 4;
    const int K = g.K, nt = K / BK;
    unsigned voffA[2], voffB[2];
#pragma unroll
    for (int i = 0; i < 2; ++i) { int R, C; stage_rc(tid * 16 + i * 8192, R, C); const int Rb = Epi::PERM ? ((R & ~31) + perm32(R & 31)) : R;
        voffA[i] = (unsigned)(R * K + C) * 2u; voffB[i] = (unsigned)(Rb * K + C) * 2u; }
    const size_t kstep = (size_t)(BK * 2);
    const size_t hstep = (size_t)HALF * K * 2;
    const size_t tstep = 2 * hstep;
    const unsigned ldsw = (unsigned)wid * 1024u;
    const int aoff = lds_byte(wr * 64 + fr, fq * 8), boff = lds_byte(wc * 32 + fr, fq * 8);
#define PG8_SA(b, h) (((b) * 2 + (h)) * HTB)
#define PG8_SB(b, h) ((4 + (b) * 2 + (h)) * HTB)
#define PG8_STAGE(bufoff, gbase, voff) do { _Pragma("unroll") for (int _i = 0; _i < 2; ++_i) \
        __builtin_amdgcn_global_load_lds((const unsigned*)((const char*)(gbase) + (voff)[_i]), (PG8_LAS unsigned*)(lds + (bufoff) + ldsw + _i * 8192), 16, 0, 0); } while (0)
#define PG8_LDA(dst, b, h) do { _Pragma("unroll") for (int m = 0; m < 4; ++m) _Pragma("unroll") for (int k = 0; k < 2; ++k) dst[m][k] = *(const PG8_LAS bf16x8*)(lds + PG8_SA(b, h) + aoff + m * 2048 + k * 1024); } while (0)
#define PG8_LDB(dst, b, h) do { _Pragma("unroll") for (int n = 0; n < 2; ++n) _Pragma("unroll") for (int k = 0; k < 2; ++k) dst[n][k] = *(const PG8_LAS bf16x8*)(lds + PG8_SB(b, h) + boff + n * 2048 + k * 1024); } while (0)
#define PG8_MMA(ai, bj, At, Bt) do { __builtin_amdgcn_s_setprio(1); _Pragma("unroll") for (int m = 0; m < 4; ++m) _Pragma("unroll") for (int n = 0; n < 2; ++n) _Pragma("unroll") for (int k = 0; k < 2; ++k) \
        acc[ai][bj][m][n] = __builtin_amdgcn_mfma_f32_16x16x32_bf16(Bt[n][k], At[m][k], acc[ai][bj][m][n], 0, 0, 0); __builtin_amdgcn_s_setprio(0); } while (0)
#define PG8_WAIT_V(n) asm volatile("s_waitcnt vmcnt(" #n ")" ::: "memory")
#define PG8_WAIT_L(n) asm volatile("s_waitcnt lgkmcnt(" #n ")" ::: "memory")
#define PG8_BAR __builtin_amdgcn_s_barrier()
#define PG8_SCHED __builtin_amdgcn_sched_barrier(0)
    Unit cur, nxt; int ui = 0;
    if (!S.next(0, cur)) return;
    f32x4 acc[2][2][4][2];
#pragma unroll
    for (int a = 0; a < 2; ++a)
#pragma unroll
        for (int b = 0; b < 2; ++b)
#pragma unroll
            for (int m = 0; m < 4; ++m)
#pragma unroll
                for (int n = 0; n < 2; ++n) acc[a][b][m][n] = (f32x4){0.f, 0.f, 0.f, 0.f};
    bf16x8 At[4][2], B0[2][2], B1[2][2];
    const char* cA = (const char*)(cur.part ? g.A2 : g.A) + (size_t)cur.pm * tstep; const char* cB = (const char*)g.Bt + (size_t)(cur.pn + cur.part * g.bpart) * tstep;
    S.a_ready(cur);
    if constexpr (SP2) {
        PG8_STAGE(PG8_SB(0, 0), cB, voffB); PG8_STAGE(PG8_SB(0, 1), cB + hstep, voffB); PG8_STAGE(PG8_SA(0, 0), cA, voffA); PG8_STAGE(PG8_SA(0, 1), cA + hstep, voffA);
        if (wr == 1) PG8_BAR;
        PG8_WAIT_V(2); PG8_BAR;
        PG8_STAGE(PG8_SB(1, 0), cB + kstep, voffB); PG8_STAGE(PG8_SA(1, 0), cA + kstep, voffA); PG8_STAGE(PG8_SB(1, 1), cB + hstep + kstep, voffB);
        PG8_WAIT_V(6); PG8_BAR;
    } else {
        PG8_STAGE(PG8_SB(0, 0), cB, voffB); PG8_STAGE(PG8_SA(0, 0), cA, voffA); PG8_STAGE(PG8_SB(0, 1), cB + hstep, voffB); PG8_STAGE(PG8_SA(0, 1), cA + hstep, voffA);
        if (wr == 1) PG8_BAR;
        PG8_WAIT_V(4); PG8_BAR;
        PG8_STAGE(PG8_SB(1, 0), cB + kstep, voffB); PG8_STAGE(PG8_SA(1, 0), cA + kstep, voffA); PG8_STAGE(PG8_SB(1, 1), cB + hstep + kstep, voffB);
        PG8_WAIT_V(6); PG8_BAR;
    }
    for (;;) {
        const bool has_next = S.next(ui + 1, nxt);
        const char* nA = has_next ? (const char*)(nxt.part ? g.A2 : g.A) + (size_t)nxt.pm * tstep : cA; const char* nB = has_next ? (const char*)g.Bt + (size_t)(nxt.pn + nxt.part * g.bpart) * tstep : cB;
        for (int t = 0; t < nt; t += 2) {
            const bool last = (t == nt - 2);
            const char* a1 = cA + (size_t)(t + 1) * kstep;
            const char* a2 = last ? nA : cA + (size_t)(t + 2) * kstep; const char* b2 = last ? nB : cB + (size_t)(t + 2) * kstep;
            const char* a3 = a2 + kstep; const char* b3 = b2 + kstep;
            if (last && has_next) S.a_ready(nxt);
            if constexpr (SP2) {
            PG8_LDB(B0, 0, 0); PG8_LDB(B1, 0, 1); PG8_SCHED; PG8_LDA(At, 0, 0); PG8_STAGE(PG8_SA(1, 1), a1 + hstep, voffA);
            PG8_WAIT_V(8); PG8_WAIT_L(0); PG8_BAR; PG8_MMA(0, 0, At, B0); PG8_MMA(0, 1, At, B1); PG8_BAR; PG8_SCHED;
            PG8_LDA(At, 0, 1); PG8_STAGE(PG8_SB(0, 0), b2, voffB); PG8_STAGE(PG8_SB(0, 1), b2 + hstep, voffB); PG8_STAGE(PG8_SA(0, 0), a2, voffA);
            PG8_WAIT_V(8); PG8_WAIT_L(0); PG8_BAR; PG8_MMA(1, 0, At, B0); PG8_MMA(1, 1, At, B1); PG8_BAR; PG8_SCHED;
            PG8_LDB(B0, 1, 0); PG8_LDB(B1, 1, 1); PG8_SCHED; PG8_LDA(At, 1, 0); PG8_STAGE(PG8_SA(0, 1), a2 + hstep, voffA);
            PG8_WAIT_V(8); PG8_WAIT_L(0); PG8_BAR; PG8_MMA(0, 0, At, B0); PG8_MMA(0, 1, At, B1); PG8_BAR; PG8_SCHED;
            PG8_LDA(At, 1, 1); PG8_STAGE(PG8_SB(1, 0), b3, voffB); PG8_STAGE(PG8_SB(1, 1), b3 + hstep, voffB); PG8_STAGE(PG8_SA(1, 0), a3, voffA);
            PG8_WAIT_V(8); PG8_WAIT_L(0); PG8_BAR; PG8_MMA(1, 0, At, B0); PG8_MMA(1, 1, At, B1); PG8_BAR; PG8_SCHED;
            } else {
            PG8_LDB(B0, 0, 0); PG8_SCHED; PG8_LDA(At, 0, 0); PG8_STAGE(PG8_SA(1, 1), a1 + hstep, voffA);
            PG8_WAIT_L(8); PG8_BAR; PG8_WAIT_L(0); PG8_MMA(0, 0, At, B0); PG8_BAR; PG8_SCHED;
            PG8_LDB(B1, 0, 1); PG8_STAGE(PG8_SB(0, 0), b2, voffB);
            PG8_BAR; PG8_WAIT_L(0); PG8_MMA(0, 1, At, B1); PG8_BAR;
            PG8_LDA(At, 0, 1); PG8_STAGE(PG8_SA(0, 0), a2, voffA);
            PG8_BAR; PG8_WAIT_L(0); PG8_MMA(1, 0, At, B0); PG8_BAR; PG8_SCHED;
            PG8_STAGE(PG8_SB(0, 1), b2 + hstep, voffB);
            PG8_WAIT_V(6); PG8_BAR; PG8_MMA(1, 1, At, B1); PG8_BAR;
            PG8_LDB(B0, 1, 0); PG8_SCHED; PG8_LDA(At, 1, 0); PG8_STAGE(PG8_SA(0, 1), a2 + hstep, voffA);
            PG8_WAIT_L(8); PG8_BAR; PG8_WAIT_L(0); PG8_MMA(0, 0, At, B0); PG8_BAR; PG8_SCHED;
            PG8_LDB(B1, 1, 1); PG8_STAGE(PG8_SB(1, 0), b3, voffB);
            PG8_BAR; PG8_WAIT_L(0); PG8_MMA(0, 1, At, B1); PG8_BAR;
            PG8_LDA(At, 1, 1); PG8_STAGE(PG8_SA(1, 0), a3, voffA);
            PG8_BAR; PG8_WAIT_L(0); PG8_MMA(1, 0, At, B0); PG8_BAR; PG8_SCHED;
            PG8_STAGE(PG8_SB(1, 1), b3 + hstep, voffB);
            PG8_WAIT_V(6); PG8_BAR; PG8_MMA(1, 1, At, B1); PG8_BAR;
            }
        }
        if constexpr (ALIGN_EPI) { if (wr == 0) PG8_BAR; }
        bool midp = false; if constexpr (Epi::TWO_PART) midp = (cur.part == 0);
        if constexpr (Epi::TWO_PART) { if (midp) E.mid(acc, cur, wr, wc, fr, fq); else E(acc, cur, wr, wc, fr, fq); } else { E(acc, cur, wr, wc, fr, fq); }
        if (!has_next) break;
        if (!midp) {
#pragma unroll
        for (int a = 0; a < 2; ++a)
#pragma unroll
            for (int b = 0; b < 2; ++b)
#pragma unroll
                for (int m = 0; m < 4; ++m)
#pragma unroll
                    for (int n = 0; n < 2; ++n) acc[a][b][m][n] = (f32x4){0.f, 0.f, 0.f, 0.f};
        }
        cur = nxt; cA = nA; cB = nB; ++ui;
        if constexpr (ALIGN_EPI) { if (wr == 1) PG8_BAR; }
    }
    PG8_WAIT_V(0);
    if constexpr (!ALIGN_EPI) { if (wr == 0) PG8_BAR; }
    PG8_BAR;
    if constexpr (Epi::AFTER_DRAIN) { E.fused(acc, cur, wr, wc, fr, fq, lds, wid, lane); S.done(cur); }
#undef PG8_SA
#undef PG8_SB
#undef PG8_STAGE
#undef PG8_LDA
#undef PG8_LDB
#undef PG8_MMA
#undef PG8_WAIT_V
#undef PG8_WAIT_L
#undef PG8_BAR
#undef PG8_SCHED
}
}
#ifndef REP_RW
#define REP_RW 1
#endif
#ifndef REP_GLA
#define REP_GLA 1
#endif

#define LAS __attribute__((address_space(3)))
typedef unsigned short bf16;
typedef float f4 __attribute__((ext_vector_type(4)));
typedef float f2 __attribute__((ext_vector_type(2)));
typedef unsigned u4 __attribute__((ext_vector_type(4)));
typedef unsigned u2 __attribute__((ext_vector_type(2)));

constexpr int NT = 512, NWAVE = 8;
constexpr int D = 1024, NBATCH = 8, SEQ = 2048, M = NBATCH * SEQ;
constexpr int RWC = 1792, GLCP = 1792, NGATE = 2048, NPROJ = 5632, NIN = 5392, DFF = 2816;
constexpr float ALPHA = 1.189207115002721f, LN_EPS = 1e-5f, GN_EPS = 64e-5f, GLA_EPS = 1e-5f;
constexpr int LDS_BYTES = 147456;

constexpr size_t MiB = 1u << 20;
constexpr size_t WS_MOD = 0, WS_SB = 1 * MiB, WS_WIN = 2 * MiB, WS_W1 = 13 * MiB, WS_W2 = 24 * MiB, WS_WBR = 30 * MiB, WS_WMIX = 32 * MiB,
                 WS_U = 36 * MiB, WS_RWP = 68 * MiB, WS_GLAP = 124 * MiB, WS_GATES = 180 * MiB, WS_MG = 68 * MiB, WS_H = 68 * MiB,
                 WS_DECG = 1 * MiB + 512 * 1024, WS_W2T = 1 * MiB + 768 * 1024, WS_A2T = WS_W2T + 65536, WS_G2T = WS_A2T + 65536, WS_KDT = 244 * MiB, WS_INVN = 252 * MiB;

__device__ __forceinline__ unsigned f2bf(float f) { unsigned u = __builtin_bit_cast(unsigned, f); return (u + 0x7fffu + ((u >> 16) & 1u)) >> 16; }
__device__ __forceinline__ unsigned pk2(float lo, float hi) { return f2bf(lo) | (f2bf(hi) << 16); }
__device__ __forceinline__ float bf2f(unsigned short b) { return __builtin_bit_cast(float, ((unsigned)b) << 16); }
__device__ __forceinline__ float bflo(unsigned w) { return __builtin_bit_cast(float, w << 16); }
__device__ __forceinline__ float bfhi(unsigned w) { return __builtin_bit_cast(float, w & 0xffff0000u); }
__device__ __forceinline__ float sigm(float x) { return 1.f / (1.f + __expf(-x)); }
__device__ __forceinline__ float wave_sum(float v) {
#pragma unroll
    for (int o = 1; o < 64; o <<= 1) v += __shfl_xor(v, o);
    return v;
}
template <int CTRL> __device__ __forceinline__ float dppf(float x) { return __builtin_bit_cast(float, __builtin_amdgcn_mov_dpp(__builtin_bit_cast(int, x), CTRL, 0xf, 0xf, true)); }
__device__ __forceinline__ float reduce16(float x) { x += dppf<0xB1>(x); x += dppf<0x4E>(x); x += dppf<0x141>(x); x += dppf<0x128>(x); return x; }
#define LDS_WAIT() asm volatile("s_waitcnt lgkmcnt(0)" ::: "memory")

struct Args { const float* in[28]; float* out; unsigned char* ws; };

struct EpiProj {
    static constexpr bool PERM = true, AFTER_DRAIN = false, TWO_PART = false;
    bf16 *RWP, *GLAP, *GATES;
    __device__ __forceinline__ void operator()(const pg8::f32x4 (&acc)[2][2][4][2], const pg8::Unit& u, int wr, int wc, int fr, int fq) const {
        bf16* base; int ldc, colt; bool sg;
        if (u.pn < 7) { base = RWP; ldc = RWC; colt = u.pn * 256; sg = false; }
        else if (u.pn < 14) { base = GLAP; ldc = GLCP; colt = (u.pn - 7) * 256; sg = false; }
        else { base = GATES; ldc = NGATE; colt = (u.pn - 14) * 256; sg = true; }
        const int row0 = u.pm * 256 + wr * 64 + fr, col0 = colt + wc * 32 + 8 * fq;
#pragma unroll
        for (int ai = 0; ai < 2; ++ai)
#pragma unroll
            for (int m = 0; m < 4; ++m) { bf16* rowp = base + (size_t)(row0 + ai * 128 + m * 16) * ldc + col0;
#pragma unroll
                for (int bj = 0; bj < 2; ++bj) { pg8::f32x4 v0 = acc[ai][bj][m][0], v1 = acc[ai][bj][m][1];
                    if (sg) {
#pragma unroll
                        for (int j = 0; j < 4; ++j) { v0[j] = sigm(v0[j]); v1[j] = sigm(v1[j]); } }
                    u4 w; w.x = pk2(v0[0], v0[1]); w.y = pk2(v0[2], v0[3]); w.z = pk2(v1[0], v1[1]); w.w = pk2(v1[2], v1[3]);
                    *(u4*)(rowp + bj * 128) = w; } }
    }
};
struct EpiGate {
    static constexpr bool PERM = true, AFTER_DRAIN = false, TWO_PART = true;
    bf16* MG; const bf16* GATES;
    __device__ __forceinline__ void mid(pg8::f32x4 (&acc)[2][2][4][2], const pg8::Unit& u, int wr, int wc, int fr, int fq) const {
        const int row0 = u.pm * 256 + wr * 64 + fr, col0 = u.pn * 256 + wc * 32 + 8 * fq;
#pragma unroll
        for (int ai = 0; ai < 2; ++ai)
#pragma unroll
            for (int m = 0; m < 4; ++m) { const size_t off = (size_t)(row0 + ai * 128 + m * 16) * NGATE + col0;
#pragma unroll
                for (int bj = 0; bj < 2; ++bj) { const u4 ga = *(const u4*)(GATES + off + bj * 128), gb = *(const u4*)(GATES + off + 1024 + bj * 128);
                    acc[ai][bj][m][0][0] *= bflo(ga.x) / bflo(gb.x); acc[ai][bj][m][0][1] *= bfhi(ga.x) / bfhi(gb.x); acc[ai][bj][m][0][2] *= bflo(ga.y) / bflo(gb.y); acc[ai][bj][m][0][3] *= bfhi(ga.y) / bfhi(gb.y);
                    acc[ai][bj][m][1][0] *= bflo(ga.z) / bflo(gb.z); acc[ai][bj][m][1][1] *= bfhi(ga.z) / bfhi(gb.z); acc[ai][bj][m][1][2] *= bflo(ga.w) / bflo(gb.w); acc[ai][bj][m][1][3] *= bfhi(ga.w) / bfhi(gb.w); } }
    }
    __device__ __forceinline__ void operator()(const pg8::f32x4 (&acc)[2][2][4][2], const pg8::Unit& u, int wr, int wc, int fr, int fq) const {
        const int row0 = u.pm * 256 + wr * 64 + fr, col0 = u.pn * 256 + wc * 32 + 8 * fq;
#pragma unroll
        for (int ai = 0; ai < 2; ++ai)
#pragma unroll
            for (int m = 0; m < 4; ++m) { const int row = row0 + ai * 128 + m * 16;
#pragma unroll
                for (int bj = 0; bj < 2; ++bj) { const pg8::f32x4 v0 = acc[ai][bj][m][0], v1 = acc[ai][bj][m][1];
                    const u4 gt = *(const u4*)(GATES + (size_t)row * NGATE + 1024 + col0 + bj * 128);
                    u4 w; w.x = pk2(v0[0] * bflo(gt.x), v0[1] * bfhi(gt.x)); w.y = pk2(v0[2] * bflo(gt.y), v0[3] * bfhi(gt.y));
                    w.z = pk2(v1[0] * bflo(gt.z), v1[1] * bfhi(gt.z)); w.w = pk2(v1[2] * bflo(gt.w), v1[3] * bfhi(gt.w));
                    *(u4*)(MG + (size_t)row * D + col0 + bj * 128) = w; } }
    }
};
struct EpiRes {
    static constexpr bool PERM = false, AFTER_DRAIN = false, TWO_PART = false;
    const float* base; float* out; const float* gate;
    __device__ __forceinline__ void operator()(const pg8::f32x4 (&acc)[2][2][4][2], const pg8::Unit& u, int wr, int wc, int fr, int fq) const {
        const int row0 = u.pm * 256 + wr * 64 + fr, col0 = u.pn * 256 + wc * 32 + 4 * fq;
        const float* gp = gate + (size_t)(u.pm >> 3) * 6144 + col0;
        pg8::f32x4 gv[2][2];
#pragma unroll
        for (int bj = 0; bj < 2; ++bj)
#pragma unroll
            for (int n = 0; n < 2; ++n) gv[bj][n] = *(const pg8::f32x4*)(gp + bj * 128 + n * 16);
#pragma unroll
        for (int ai = 0; ai < 2; ++ai)
#pragma unroll
            for (int m = 0; m < 4; ++m) { const size_t off = (size_t)(row0 + ai * 128 + m * 16) * D + col0;
#pragma unroll
                for (int bj = 0; bj < 2; ++bj)
#pragma unroll
                    for (int n = 0; n < 2; ++n) { const pg8::f32x4 bs = *(const pg8::f32x4*)(base + off + bj * 128 + n * 16);
                        *(pg8::f32x4*)(out + off + bj * 128 + n * 16) = bs * ALPHA + gv[bj][n] * acc[ai][bj][m][n]; } }
    }
};
struct EpiSwiGLU {
    static constexpr bool PERM = true, AFTER_DRAIN = false, TWO_PART = false;
    bf16* H;
    __device__ __forceinline__ void operator()(const pg8::f32x4 (&acc)[2][2][4][2], const pg8::Unit& u, int wr, int wc, int fr, int fq) const {
        const int row0 = u.pm * 256 + wr * 64 + fr, col0 = u.pn * 128 + wc * 32 + 8 * fq;
#pragma unroll
        for (int ai = 0; ai < 2; ++ai)
#pragma unroll
            for (int m = 0; m < 4; ++m) { bf16* rowp = H + (size_t)(row0 + ai * 128 + m * 16) * DFF + col0;
                float h[8];
#pragma unroll
                for (int n = 0; n < 2; ++n)
#pragma unroll
                    for (int j = 0; j < 4; ++j) { const float g = acc[ai][0][m][n][j], up = acc[ai][1][m][n][j]; h[n * 4 + j] = g * sigm(g) * up; }
                u4 w; w.x = pk2(h[0], h[1]); w.y = pk2(h[2], h[3]); w.z = pk2(h[4], h[5]); w.w = pk2(h[6], h[7]);
                *(u4*)rowp = w; }
    }
};

__device__ __forceinline__ void p0_mod(const float* c, const float* w_ada, const float* b_ada, float* MOD, LAS float* ldsf) {
    const int tid = threadIdx.x;
    for (int cb = blockIdx.x; cb < 192; cb += gridDim.x) {
        LAS float* sc = ldsf; LAS float* red = ldsf + 8192;
        for (int i = tid; i < 8192; i += NT) { const float v = c[i]; sc[i] = v * sigm(v); }
        __syncthreads();
        const int cc = tid & 31, kp = tid >> 5, j = cb * 32 + cc;
        float acc[8];
#pragma unroll
        for (int b = 0; b < 8; ++b) acc[b] = 0.f;
#pragma unroll
        for (int hh = 0; hh < 2; ++hh) { float wv[32];
#pragma unroll
            for (int i = 0; i < 32; ++i) wv[i] = w_ada[(size_t)(kp + 16 * (hh * 32 + i)) * 6144 + j];
#pragma unroll
            for (int i = 0; i < 32; ++i) { const int k = kp + 16 * (hh * 32 + i);
#pragma unroll
                for (int b = 0; b < 8; ++b) acc[b] += sc[b * 1024 + k] * wv[i]; } }
#pragma unroll
        for (int b = 0; b < 8; ++b) red[(kp * 8 + b) * 32 + cc] = acc[b];
        __syncthreads();
        if (tid < 256) { const int b = tid >> 5; float s = 0.f;
#pragma unroll
            for (int q = 0; q < 16; ++q) s += red[(q * 8 + b) * 32 + cc];
            MOD[b * 6144 + j] = s + b_ada[j]; }
        __syncthreads();
    }
}
__device__ __forceinline__ int rowmap(int mode, int n) {
    if (mode == 1) return n < 3344 ? n : n + 240;
    if (mode == 2) { const int j = n < 2816 ? n : n - 2816; return (j >> 7) * 256 + (n < 2816 ? 0 : 128) + (j & 127); }
    return n;
}
__device__ __forceinline__ void tr_item(const float* W, int K, int N, bf16* WT, int ldt, int koff, int row_off, int mode, LAS float* scr, int item, int lane) {
    const int nblk = (N + 31) / 32, kb = item / nblk, nb = item % nblk, k0 = 64 * kb, n0 = 32 * nb;
    const int ncol = n0 + (lane & 31); const bool okc = ncol < N;
    float tv[32];
#pragma unroll
    for (int i = 0; i < 32; ++i) { const int kk = 2 * i + (lane >> 5); tv[i] = okc ? W[(size_t)(k0 + kk) * N + ncol] : 0.f; }
#pragma unroll
    for (int i = 0; i < 32; ++i) { const int kk = 2 * i + (lane >> 5); scr[kk * 33 + (lane & 31)] = tv[i]; }
    LDS_WAIT();
    const int c = lane & 7;
#pragma unroll
    for (int j = 0; j < 4; ++j) { const int n = (lane >> 3) + 8 * j; const LAS float* s = scr + (8 * c) * 33 + n;
        u4 o; o.x = pk2(s[0 * 33], s[1 * 33]); o.y = pk2(s[2 * 33], s[3 * 33]); o.z = pk2(s[4 * 33], s[5 * 33]); o.w = pk2(s[6 * 33], s[7 * 33]);
        if (n0 + n < N) *(u4*)(WT + (size_t)(rowmap(mode, n0 + n) + row_off) * ldt + koff + k0 + 8 * c) = o; }
    LDS_WAIT();
}
__device__ __forceinline__ void p0_weights(const Args& a, LAS float* ldsf) {
    const int tid = threadIdx.x, lane = tid & 63, wave = tid >> 6;
    LAS float* scr = ldsf + wave * 4096;
    const int gw = blockIdx.x * NWAVE + wave, NGW = gridDim.x * NWAVE;
    bf16* WinT = (bf16*)(a.ws + WS_WIN); bf16* W1T = (bf16*)(a.ws + WS_W1); bf16* W2T = (bf16*)(a.ws + WS_W2); bf16* WbrT = (bf16*)(a.ws + WS_WBR); bf16* WmixT = (bf16*)(a.ws + WS_WMIX);
    constexpr int I_IN = 16 * 169, I_F1 = 16 * 176, I_F2 = 44 * 32, I_BR = 8 * 32, I_MX = 16 * 32, I_L1 = 16, I_L2 = 32;
    constexpr int NITEMS = I_IN + I_F1 + I_F2 + 2 * I_BR + I_MX + 2 * I_L1 + I_L2;
    for (int it = gw; it < NITEMS; it += NGW) {
        int r = it;
        if (r < I_IN) { tr_item(a.in[4], 1024, NIN, WinT, 1024, 0, 0, 1, scr, r, lane); continue; } r -= I_IN;
        if (r < I_F1) { tr_item(a.in[24], 1024, 2 * DFF, W1T, 1024, 0, 0, 2, scr, r, lane); continue; } r -= I_F1;
        if (r < I_F2) { tr_item(a.in[25], DFF, 1024, W2T, DFF, 0, 0, 0, scr, r, lane); continue; } r -= I_F2;
        if (r < I_BR) { tr_item(a.in[19], 512, 1024, WbrT, 512, 0, 0, 0, scr, r, lane); continue; } r -= I_BR;
        if (r < I_BR) { tr_item(a.in[20], 512, 1024, WbrT, 512, 0, 1024, 0, scr, r, lane); continue; } r -= I_BR;
        if (r < I_MX) { tr_item(a.in[21], 1024, 1024, WmixT, 1024, 0, 0, 0, scr, r, lane); continue; } r -= I_MX;
        if (r < I_L1) { tr_item(a.in[7], 64, 512, (bf16*)(a.ws + WS_W2T), 64, 0, 0, 0, scr, r, lane); continue; } r -= I_L1;
        if (r < I_L1) { tr_item(a.in[9], 64, 512, (bf16*)(a.ws + WS_A2T), 64, 0, 0, 0, scr, r, lane); continue; } r -= I_L1;
        tr_item(a.in[10], 128, 512, (bf16*)(a.ws + WS_G2T), 128, 0, 0, 0, scr, r, lane);
    }
    const u4 z = {0u, 0u, 0u, 0u};
    for (int i = blockIdx.x * NT + tid; i < 240 * 128; i += gridDim.x * NT) *((u4*)(WinT + (size_t)3344 * 1024) + i) = z;
}
__device__ __forceinline__ void p1_modulate(const float* __restrict__ x, const float* __restrict__ MOD, bf16* __restrict__ U) {
    const int tid = threadIdx.x, lane = tid & 63, wave = tid >> 6;
    const int gw = blockIdx.x * NWAVE + wave, NGW = gridDim.x * NWAVE;
    for (int m = gw; m < M; m += 2 * NGW) {
        const int m2 = m + NGW;
        const bool has2 = m2 < M; const int mm2 = has2 ? m2 : m;
        const int b = m >> 11, b2 = mm2 >> 11;
        const f4* xr = (const f4*)(x + (size_t)m * D) + lane; const f4* xr2 = (const f4*)(x + (size_t)mm2 * D) + lane;
        const f4* sh = (const f4*)(MOD + b * 6144) + lane; const f4* sc = (const f4*)(MOD + b * 6144 + 1024) + lane;
        const f4* sh2 = (const f4*)(MOD + b2 * 6144) + lane; const f4* sc2 = (const f4*)(MOD + b2 * 6144 + 1024) + lane;
        f4 v[4], s[4], h[4], v2[4], s2[4], h2[4];
#pragma unroll
        for (int j = 0; j < 4; ++j) { v[j] = xr[64 * j]; v2[j] = xr2[64 * j]; s[j] = sc[64 * j]; h[j] = sh[64 * j]; s2[j] = sc2[64 * j]; h2[j] = sh2[64 * j]; }
        u2* o = (u2*)(U + (size_t)m * D) + lane; u2* o2 = (u2*)(U + (size_t)mm2 * D) + lane;
#pragma unroll
        for (int j = 0; j < 4; ++j) { const f4 r = v[j] * (s[j] + 1.0f) + h[j]; u2 w; w.x = pk2(r.x, r.y); w.y = pk2(r.z, r.w); o[64 * j] = w; }
        if (has2) {
#pragma unroll
            for (int j = 0; j < 4; ++j) { const f4 r = v2[j] * (s2[j] + 1.0f) + h2[j]; u2 w; w.x = pk2(r.x, r.y); w.y = pk2(r.z, r.w); o2[64 * j] = w; } }
    }
}
__device__ __forceinline__ void p3_lora(const Args& a, LAS unsigned char* L) {
    typedef short bf16x8 __attribute__((ext_vector_type(8)));
    const int tid = threadIdx.x, lane = tid & 63, wave = tid >> 6, fr = lane & 15, fq = lane >> 4;
    const bf16* __restrict__ RWP = (const bf16*)(a.ws + WS_RWP);
    const float* mu = a.in[5]; const float* w0 = a.in[6]; const float* a0 = a.in[8];
    float* E = a.out; bf16* A = (bf16*)(a.out + (size_t)8 * MiB); bf16* G = (bf16*)(a.out + (size_t)12 * MiB);
    float* INVN = (float*)(a.ws + WS_INVN); float* SB = (float*)(a.ws + WS_SB);
    const bf16* w2T = (const bf16*)(a.ws + WS_W2T); const bf16* a2T = (const bf16*)(a.ws + WS_A2T); const bf16* g2T = (const bf16*)(a.ws + WS_G2T);
    constexpr int PW = 72, PG = 136;
    LAS bf16* TW = (LAS bf16*)L; LAS bf16* TA = TW + 32 * PW; LAS bf16* TG = TA + 32 * PW; LAS float* AVL = (LAS float*)(TG + 32 * PG);
    float w0c[4], a0c[4];
#pragma unroll
    for (int nt = 0; nt < 4; ++nt) { w0c[nt] = w0[64 * wave + 16 * nt + fr]; a0c[nt] = a0[64 * wave + 16 * nt + fr]; }
    const int j = tid;
    const float kkw = a.in[11][j], kaw = a.in[12][j], rkw = a.in[13][j], mu_r = mu[j], mu_k = mu[512 + j];
    for (int tile = blockIdx.x; tile < M / 32; tile += gridDim.x) {
        const int m0 = tile * 32;
        __syncthreads();
        { float p[16], pp[16];
#pragma unroll
          for (int i = 0; i < 16; ++i) { const int e = tid + i * NT, tl = e >> 8, ci = e & 255, col = 1536 + ci, m = m0 + tl; const size_t mq = (m & 2047) ? (size_t)(m - 1) : (size_t)m;
            p[i] = bf2f(RWP[(size_t)m * RWC + col]); pp[i] = bf2f(RWP[mq * RWC + col]); }
#pragma unroll
          for (int i = 0; i < 16; ++i) { const int e = tid + i * NT, tl = e >> 8, ci = e & 255, col = 1536 + ci, m = m0 + tl;
            const float pq = (m & 2047) ? pp[i] : 0.f; const float ps = p[i] + mu[col] * (pq - p[i]);
            if (ci < 64) TW[tl * PW + ci] = (bf16)f2bf(tanhf(ps)); else if (ci < 128) TA[tl * PW + ci - 64] = (bf16)f2bf(ps); else TG[tl * PG + ci - 128] = (bf16)f2bf(sigm(ps)); } }
        __syncthreads();
#pragma unroll
        for (int mt = 0; mt < 2; ++mt) { const bf16x8 af0 = *(const LAS bf16x8*)(TW + (16 * mt + fr) * PW + 8 * fq), af1 = *(const LAS bf16x8*)(TW + (16 * mt + fr) * PW + 32 + 8 * fq);
#pragma unroll
            for (int nt = 0; nt < 4; ++nt) { const bf16* bp = w2T + (size_t)(64 * wave + 16 * nt + fr) * 64 + 8 * fq; const bf16x8 b0 = *(const bf16x8*)bp, b1 = *(const bf16x8*)(bp + 32);
                pg8::f32x4 acc = {0.f, 0.f, 0.f, 0.f}; acc = __builtin_amdgcn_mfma_f32_16x16x32_bf16(af0, b0, acc, 0, 0, 0); acc = __builtin_amdgcn_mfma_f32_16x16x32_bf16(af1, b1, acc, 0, 0, 0);
#pragma unroll
                for (int jj = 0; jj < 4; ++jj) E[(size_t)(m0 + 16 * mt + 4 * fq + jj) * 512 + 64 * wave + 16 * nt + fr] = 0.6065306597126334f * sigm(w0c[nt] + acc[jj]); } }
#pragma unroll
        for (int mt = 0; mt < 2; ++mt) { const bf16x8 af0 = *(const LAS bf16x8*)(TA + (16 * mt + fr) * PW + 8 * fq), af1 = *(const LAS bf16x8*)(TA + (16 * mt + fr) * PW + 32 + 8 * fq);
#pragma unroll
            for (int nt = 0; nt < 4; ++nt) { const bf16* bp = a2T + (size_t)(64 * wave + 16 * nt + fr) * 64 + 8 * fq; const bf16x8 b0 = *(const bf16x8*)bp, b1 = *(const bf16x8*)(bp + 32);
                pg8::f32x4 acc = {0.f, 0.f, 0.f, 0.f}; acc = __builtin_amdgcn_mfma_f32_16x16x32_bf16(af0, b0, acc, 0, 0, 0); acc = __builtin_amdgcn_mfma_f32_16x16x32_bf16(af1, b1, acc, 0, 0, 0);
#pragma unroll
                for (int jj = 0; jj < 4; ++jj) { const float av = sigm(a0c[nt] + acc[jj]); const int tl = 16 * mt + 4 * fq + jj, col = 64 * wave + 16 * nt + fr;
                    A[(size_t)(m0 + tl) * 512 + col] = (bf16)f2bf(av); AVL[tl * 512 + col] = av; } } }
#pragma unroll
        for (int mt = 0; mt < 2; ++mt) { bf16x8 af[4];
#pragma unroll
            for (int ks = 0; ks < 4; ++ks) af[ks] = *(const LAS bf16x8*)(TG + (16 * mt + fr) * PG + 32 * ks + 8 * fq);
#pragma unroll
            for (int nt = 0; nt < 4; ++nt) { const bf16* bp = g2T + (size_t)(64 * wave + 16 * nt + fr) * 128 + 8 * fq; pg8::f32x4 acc = {0.f, 0.f, 0.f, 0.f};
#pragma unroll
                for (int ks = 0; ks < 4; ++ks) acc = __builtin_amdgcn_mfma_f32_16x16x32_bf16(af[ks], *(const bf16x8*)(bp + 32 * ks), acc, 0, 0, 0);
#pragma unroll
                for (int jj = 0; jj < 4; ++jj) G[(size_t)(m0 + 16 * mt + 4 * fq + jj) * 512 + 64 * wave + 16 * nt + fr] = (bf16)f2bf(acc[jj]); } }
        __syncthreads();
#pragma unroll
        for (int q = 0; q < 8; ++q) {
            float rv_[5], kv_[5];
#pragma unroll
            for (int i = 0; i < 5; ++i) { const int m = m0 + 4 * q + i - 1; const bool ok = (i > 0) || ((m + 1) & 2047); const size_t mm = ok ? (size_t)m : (size_t)(m + 1);
                rv_[i] = bf2f(RWP[mm * RWC + j]); kv_[i] = bf2f(RWP[mm * RWC + 512 + j]); if (!ok) { rv_[i] = 0.f; kv_[i] = 0.f; } }
#pragma unroll
            for (int i = 0; i < 4; ++i) { const int m = m0 + 4 * q + i; const float av = AVL[(4 * q + i) * 512 + j];
                const float r = rv_[i + 1] + mu_r * (rv_[i] - rv_[i + 1]), k = kv_[i + 1] + mu_k * (kv_[i] - kv_[i + 1]);
                const float kkv = k * kkw; float n2 = reduce16(kkv * kkv); n2 += __shfl_xor(n2, 16); n2 += __shfl_xor(n2, 32);
                const float k2 = k * (1.f + (av - 1.f) * kaw); float sb = reduce16(r * k2 * rkw); sb += __shfl_xor(sb, 16); sb += __shfl_xor(sb, 32);
                if (lane == 0) { INVN[(size_t)m * 8 + wave] = 1.f / fmaxf(sqrtf(n2), 1e-12f); SB[(size_t)m * 8 + wave] = sb; } } }
    }
}
__device__ __forceinline__ void gla_pre(const Args& a, LAS float* ldsf) {
    const int tid = threadIdx.x, dd = tid & 63, tg = tid >> 6;
    bf16* GLAP = (bf16*)(a.ws + WS_GLAP); bf16* KDT = (bf16*)(a.ws + WS_KDT); float* DECG = (float*)(a.ws + WS_DECG);
    const float* ga2 = a.in[16]; const float* gab = a.in[17];
    LAS float* AD = ldsf; LAS float* GT = ldsf + 1024;
    for (int u = blockIdx.x; u < 1024; u += gridDim.x) {
        const int bh = u >> 5, c = u & 31, b = bh >> 2, h = bh & 3; const size_t m0 = (size_t)b * SEQ + (size_t)c * 64;
        float a2r[16];
#pragma unroll
        for (int j = 0; j < 16; ++j) a2r[j] = ga2[j * 256 + h * 64 + dd];
        const float abr = gab[h * 64 + dd];
        float qv[8], kv[8];
#pragma unroll
        for (int i = 0; i < 8; ++i) { const bf16* p = GLAP + (m0 + tg * 8 + i) * GLCP + h * 64 + dd; qv[i] = bf2f(p[0]); kv[i] = bf2f(p[256]); }
        __syncthreads();
#pragma unroll
        for (int i = 0; i < 2; ++i) { const int e = tid + NT * i, t = e >> 4, j = e & 15; AD[e] = bf2f(GLAP[(m0 + t) * GLCP + 1536 + j]); }
        __syncthreads();
        float bl[8]; float run = 0.f;
#pragma unroll
        for (int i = 0; i < 8; ++i) { const int t = tg * 8 + i; float z = abr;
#pragma unroll
            for (int j4 = 0; j4 < 4; ++j4) { const f4 av = *(const LAS f4*)(AD + t * 16 + 4 * j4); z += av.x * a2r[4 * j4] + av.y * a2r[4 * j4 + 1] + av.z * a2r[4 * j4 + 2] + av.w * a2r[4 * j4 + 3]; }
            const float ls = fminf(z, 0.f) - __logf(1.f + __expf(-fabsf(z)));
            run += ls * 0.0625f; bl[i] = run; }
        GT[tg * 64 + dd] = run;
        __syncthreads();
        float off = 0.f, tot = 0.f;
#pragma unroll
        for (int g = 0; g < 8; ++g) { const float gv = GT[g * 64 + dd]; off += (g < tg) ? gv : 0.f; tot += gv; }
        unsigned kd[4];
#pragma unroll
        for (int i = 0; i < 8; ++i) { const float bc = bl[i] + off; bf16* p = GLAP + (m0 + tg * 8 + i) * GLCP + h * 64 + dd;
            p[0] = (bf16)f2bf(qv[i] * 0.125f * __expf(bc)); p[256] = (bf16)f2bf(kv[i] * __expf(-bc));
            const unsigned kdb = f2bf(kv[i] * __expf(tot - bc)); if (i & 1) kd[i >> 1] |= kdb << 16; else kd[i >> 1] = kdb; }
        *(u4*)(KDT + ((size_t)u * 64 + dd) * 64 + tg * 8) = (u4){kd[0], kd[1], kd[2], kd[3]};
        if (tg == 0) DECG[u * 64 + dd] = __expf(tot);
    }
}
__device__ __forceinline__ void rw_scan_unit(const Args& a, LAS float* ldsf, int unit) {
    const int tid = threadIdx.x, lane = tid & 63, wave = tid >> 6;
    const int bh = unit >> 2, qr = unit & 3, b = bh >> 3, h = bh & 7;
    const bf16* RWP = (const bf16*)(a.ws + WS_RWP);
    const float* E = a.out; const bf16* A = (const bf16*)(a.out + (size_t)8 * MiB);
    bf16* Yraw = (bf16*)(a.ws + WS_U);
    const float* mu = a.in[5];
    const int col = h * 64 + lane;
    const float mu_r = mu[col], mu_k = mu[512 + col], mu_v = mu[1024 + col];
    const float kkw = a.in[11][col], kaw = a.in[12][col];
    constexpr int BUF = 6 * 2048, NCH = 64 * REP_RW;
    LAS float* Ybuf = ldsf + 2 * BUF;
    const int rowl = (tid >> 4) & 15, kq = tid & 15;
    const size_t mb = (size_t)b * SEQ;
    const int pw = wave & 3;
    unsigned short rrA[9], rkA[9], rvA[9], raA[8]; float reA[8], rnA[8];
    unsigned short rrB[9], rkB[9], rvB[9], raB[8]; float reB[8], rnB[8];
    const float* INVN = (const float*)(a.ws + WS_INVN);
#define RW_LOAD(c, S) do { const int t0 = (c) * 32 + 8 * pw; const bf16* p = RWP + (mb + t0) * RWC + col; const bf16* q = t0 ? p - RWC : p; rr##S[0] = q[0]; rk##S[0] = q[512]; rv##S[0] = q[1024]; \
        _Pragma("unroll") for (int i = 0; i < 8; ++i) { rr##S[i + 1] = p[(size_t)i * RWC]; rk##S[i + 1] = p[(size_t)i * RWC + 512]; rv##S[i + 1] = p[(size_t)i * RWC + 1024]; \
            re##S[i] = E[(mb + t0 + i) * 512 + col]; ra##S[i] = A[(mb + t0 + i) * 512 + col]; rn##S[i] = INVN[(mb + t0 + i) * 8 + h]; } } while (0)
#define RW_FINAL(c, buf, S) do { LAS float* B_ = ldsf + (buf) * BUF; const int t0 = (c) * 32 + 8 * pw; _Pragma("unroll") for (int i = 0; i < 8; ++i) { const int tl = 8 * pw + i; \
        const float rp = bf2f(rr##S[i + 1]), kp = bf2f(rk##S[i + 1]), vp = bf2f(rv##S[i + 1]); const bool has = (t0 + i) != 0; \
        const float rq = has ? bf2f(rr##S[i]) : 0.f, kq_ = has ? bf2f(rk##S[i]) : 0.f, vq = has ? bf2f(rv##S[i]) : 0.f; \
        const float r = rp + mu_r * (rq - rp), k = kp + mu_k * (kq_ - kp), v = vp + mu_v * (vq - vp); \
        const float av = bf2f(ra##S[i]); const float dec = __expf(-re##S[i]); \
        const float kkn = k * kkw * rn##S[i]; const float k2 = k * (1.f + (av - 1.f) * kaw); const float bb = kkn * av; \
        B_[0 * 2048 + tl * 64 + lane] = r; B_[1 * 2048 + tl * 64 + lane] = dec; B_[2 * 2048 + tl * 64 + lane] = k2; \
        B_[3 * 2048 + tl * 64 + lane] = v; B_[4 * 2048 + tl * 64 + lane] = -kkn; B_[5 * 2048 + tl * 64 + lane] = bb; } } while (0)
#define RW_YOUT(c) do { const LAS float* Y_ = Ybuf + ((c) & 1) * 512; const int e = (tid - 256) * 2, tl = e >> 4, rl = e & 15; const f2 yv = *(const LAS f2*)(Y_ + e); \
        *(unsigned*)(Yraw + (mb + (size_t)(c) * 32 + tl) * 512 + h * 64 + qr * 16 + rl) = pk2(yv.x, yv.y); } while (0)
#define RW_CONSUME(cc) RW_CONSUME_(cc, 0, sA, sB)
#define RW_OPS(P_, tl_) P_##r4 = *(const LAS f4*)(Bc + 0 * 2048 + (tl_) * 64); P_##w4 = *(const LAS f4*)(Bc + 1 * 2048 + (tl_) * 64); P_##k4 = *(const LAS f4*)(Bc + 2 * 2048 + (tl_) * 64); \
                         P_##n4 = *(const LAS f4*)(Bc + 4 * 2048 + (tl_) * 64); P_##b4 = *(const LAS f4*)(Bc + 5 * 2048 + (tl_) * 64); P_##v1 = Vc[(tl_) * 64];
#define RW_UPDATE(sa_) do { const f2 vkA = (f2){c_k4.x, c_k4.y} * c_v1, vkB = (f2){c_k4.z, c_k4.w} * c_v1; const f2 sa2 = {sa_, sa_}; \
                const f2 tA = __builtin_elementwise_fma(sa2, (f2){c_b4.x, c_b4.y}, vkA), tB = __builtin_elementwise_fma(sa2, (f2){c_b4.z, c_b4.w}, vkB); \
                sA = __builtin_elementwise_fma(sA, (f2){c_w4.x, c_w4.y}, tA); sB = __builtin_elementwise_fma(sB, (f2){c_w4.z, c_w4.w}, tB); } while (0)
#define RW_CONSUME_(cc, YOFF, sA, sB) do { \
            const LAS float* Bc = ldsf + ((cc) & 1) * BUF + 4 * kq; \
            LAS float* Yw = (kq == 0) ? (Ybuf + (YOFF) + ((cc) & 1) * 512 + rowl) : (Ybuf + 2048 + tid); const int ystr = (kq == 0) ? 16 : 0; \
            const LAS float* Vc = ldsf + ((cc) & 1) * BUF + 3 * 2048 + qr * 16 + rowl; \
            f4 rprev, c_r4, c_w4, c_k4, c_n4, c_b4, x_r4, x_w4, x_k4, x_n4, x_b4; float c_v1, x_v1; \
            RW_OPS(c_, 0) RW_OPS(x_, 1) \
            { f2 pp = sA * (f2){c_n4.x, c_n4.y}; pp = __builtin_elementwise_fma(sB, (f2){c_n4.z, c_n4.w}, pp); const float sa = reduce16(pp.x + pp.y); RW_UPDATE(sa); rprev = c_r4; } \
            _Pragma("unroll 2") for (int tl = 1; tl < 32; ++tl) { \
                c_r4 = x_r4; c_w4 = x_w4; c_k4 = x_k4; c_n4 = x_n4; c_b4 = x_b4; c_v1 = x_v1; \
                RW_OPS(x_, (tl + 1) & 31) \
                f2 pp = sA * (f2){c_n4.x, c_n4.y}; f2 yy = sA * (f2){rprev.x, rprev.y}; \
                pp = __builtin_elementwise_fma(sB, (f2){c_n4.z, c_n4.w}, pp); yy = __builtin_elementwise_fma(sB, (f2){rprev.z, rprev.w}, yy); \
                float p = pp.x + pp.y, y = yy.x + yy.y; \
                p += dppf<0xB1>(p); y += dppf<0xB1>(y); p += dppf<0x4E>(p); y += dppf<0x4E>(y); p += dppf<0x141>(p); y += dppf<0x141>(y); p += dppf<0x128>(p); y += dppf<0x128>(y); \
                Yw[(tl - 1) * ystr] = y; \
                RW_UPDATE(p); rprev = c_r4; } \
            { f2 yy = sA * (f2){rprev.x, rprev.y}; yy = __builtin_elementwise_fma(sB, (f2){rprev.z, rprev.w}, yy); const float y = reduce16(yy.x + yy.y); Yw[31 * ystr] = y; } } while (0)
#define RW_PRODUCE(cc, SL, SF) do { if ((cc) > 0) RW_YOUT(((cc) - 1) & 63); if ((cc) + 1 < NCH) { RW_LOAD(((cc) + 2) & 63, SL); RW_FINAL(((cc) + 1) & 63, ((cc) + 1) & 1, SF); } } while (0)
#ifndef REP_CONS
#define REP_CONS 1
#endif
#ifndef REP_PROD
#define REP_PROD 1
#endif
#define RW_CONS2(cc) do { if (REP_CONS > 1) { const f2 sA0 = sA, sB0 = sB; RW_CONSUME(cc); sA = sA0; sB = sB0; } RW_CONSUME(cc); } while (0)
#define RW_PROD2(cc, SF) do { if (REP_PROD > 1 && (cc) + 1 < NCH) { RW_FINAL(((cc) + 1) & 63, ((cc) + 1) & 1, SF); } } while (0)
    __syncthreads();
    if (wave >= 4) { RW_LOAD(0, A); RW_LOAD(1, B); RW_FINAL(0, 0, A); }
    __syncthreads();
#ifndef DUP_CONS
#define DUP_CONS 0
#endif
    f2 sA = {0.f, 0.f}, sB = {0.f, 0.f}; f2 dA = {0.f, 0.f}, dB = {0.f, 0.f};
    for (int cc_ = 0; cc_ < NCH; cc_ += 2) {
        if (wave < 4) { if (REP_RW > 1 && (cc_ & 63) == 0) { sA = (f2){0.f, 0.f}; sB = (f2){0.f, 0.f}; } RW_CONS2(cc_); } else { RW_PRODUCE(cc_, A, B); RW_PROD2(cc_, B); if (DUP_CONS) RW_CONSUME_(cc_, 1024, dA, dB); }
        __syncthreads();
        if (wave < 4) { RW_CONS2(cc_ + 1); } else { RW_PRODUCE(cc_ + 1, B, A); RW_PROD2(cc_ + 1, A); if (DUP_CONS) RW_CONSUME_(cc_ + 1, 1024, dA, dB); }
        __syncthreads();
    }
    if (wave >= 4) RW_YOUT((NCH - 1) & 63);
#undef RW_LOAD
#undef RW_FINAL
#undef RW_YOUT
#undef RW_CONSUME
#undef RW_CONSUME_
#undef RW_OPS
#undef RW_UPDATE
#undef RW_PRODUCE
}
__device__ __forceinline__ void gla_unit(const Args& a, LAS unsigned char* L, int unit) {
    typedef short bf16x8 __attribute__((ext_vector_type(8)));
    const int tid = threadIdx.x, lane = tid & 63, wave = tid >> 6, fr = lane & 15, fq = lane >> 4;
    const int bh = unit >> 3, vs = unit & 7, b = bh >> 2, h = bh & 3;
    const bf16* GLAP = (const bf16*)(a.ws + WS_GLAP); bf16* Oraw = (bf16*)(a.ws + WS_U + 16 * MiB);
    const bf16* KDT = (const bf16*)(a.ws + WS_KDT); const float* DECG = (const float*)(a.ws + WS_DECG);
    constexpr int P = 72;
    LAS bf16* Qs = (LAS bf16*)L; LAS bf16* Ks = Qs + 64 * P; LAS bf16* Kdt = Ks + 64 * P; LAS bf16* Att = Kdt + 64 * P;
    LAS bf16* Vt = Att + 64 * P; LAS bf16* St = Vt + 16 * P;
    LAS float* DEC = (LAS float*)(St + 2 * 16 * P);
    const size_t mb = (size_t)b * SEQ;
    constexpr int NCH = 32 * REP_GLA;
    const int lt = tid >> 3, lp = tid & 7;
    u4 pq, pk, pd, pv; float pdec;
#define GLA_LOAD(c) do { const size_t m0 = mb + (size_t)(c) * 64; const bf16* p = GLAP + (m0 + lt) * GLCP + h * 64 + lp * 8; pq = *(const u4*)p; pk = *(const u4*)(p + 256); \
        const int uc = bh * 32 + (c); pd = *(const u4*)(KDT + ((size_t)uc * 64 + lt) * 64 + lp * 8); \
        if (tid < 128) pv = *(const u4*)(GLAP + (m0 + (tid >> 1)) * GLCP + 512 + h * 128 + vs * 16 + (tid & 1) * 8); \
        if (tid < 64) pdec = DECG[uc * 64 + tid]; } while (0)
#define GLA_STORE() do { *(LAS u4*)(Qs + lt * P + lp * 8) = pq; *(LAS u4*)(Ks + lt * P + lp * 8) = pk; *(LAS u4*)(Kdt + lt * P + lp * 8) = pd; \
        if (tid < 128) { const int t = tid >> 1, v0 = (tid & 1) * 8; Vt[(v0 + 0) * P + t] = (bf16)(pv.x & 0xffffu); Vt[(v0 + 1) * P + t] = (bf16)(pv.x >> 16); Vt[(v0 + 2) * P + t] = (bf16)(pv.y & 0xffffu); Vt[(v0 + 3) * P + t] = (bf16)(pv.y >> 16); \
            Vt[(v0 + 4) * P + t] = (bf16)(pv.z & 0xffffu); Vt[(v0 + 5) * P + t] = (bf16)(pv.z >> 16); Vt[(v0 + 6) * P + t] = (bf16)(pv.w & 0xffffu); Vt[(v0 + 7) * P + t] = (bf16)(pv.w >> 16); } \
        if (tid < 64) DEC[tid] = pdec; } while (0)
    __syncthreads();
    for (int i = tid; i < 2 * 16 * P; i += NT) St[i] = 0;
    GLA_LOAD(0); GLA_STORE();
    pg8::f32x4 Sacc = {0.f, 0.f, 0.f, 0.f};
    __syncthreads();
    for (int cc_ = 0; cc_ < NCH; ++cc_) {
        const int c = cc_ & 31;
        if (REP_GLA > 1 && c == 0 && cc_ > 0) { Sacc = (pg8::f32x4){0.f, 0.f, 0.f, 0.f}; for (int i = tid; i < 2 * 16 * P; i += NT) St[i] = 0; __syncthreads(); }
        if (cc_ + 1 < NCH) GLA_LOAD((cc_ + 1) & 31);
        { const int mt = wave >> 1;
          const bf16x8 qa0 = *(const LAS bf16x8*)(Qs + (16 * mt + fr) * P + fq * 8), qa1 = *(const LAS bf16x8*)(Qs + (16 * mt + fr) * P + 32 + fq * 8);
#pragma unroll
          for (int u = 0; u < 2; ++u) { const int nt = 2 * (wave & 1) + u; pg8::f32x4 acc = {0.f, 0.f, 0.f, 0.f};
            if (nt <= mt) { const bf16x8 kb0 = *(const LAS bf16x8*)(Ks + (16 * nt + fr) * P + fq * 8), kb1 = *(const LAS bf16x8*)(Ks + (16 * nt + fr) * P + 32 + fq * 8);
                acc = __builtin_amdgcn_mfma_f32_16x16x32_bf16(qa0, kb0, acc, 0, 0, 0); acc = __builtin_amdgcn_mfma_f32_16x16x32_bf16(qa1, kb1, acc, 0, 0, 0); }
#pragma unroll
            for (int j = 0; j < 4; ++j) { const bool keep = (nt < mt) || (nt == mt && fr <= fq * 4 + j); Att[(16 * mt + fq * 4 + j) * P + 16 * nt + fr] = (bf16)f2bf(keep ? acc[j] : 0.f); } } }
        __syncthreads();
        { const LAS bf16* Sc = St + (cc_ & 1) * 16 * P; LAS bf16* Sn = St + ((cc_ + 1) & 1) * 16 * P;
          const bf16x8 vb0 = *(const LAS bf16x8*)(Vt + fr * P + fq * 8), vb1 = *(const LAS bf16x8*)(Vt + fr * P + 32 + fq * 8);
          if (wave < 4) { const int mt = wave; pg8::f32x4 acc = {0.f, 0.f, 0.f, 0.f};
            const bf16x8 aa0 = *(const LAS bf16x8*)(Att + (16 * mt + fr) * P + fq * 8), aa1 = *(const LAS bf16x8*)(Att + (16 * mt + fr) * P + 32 + fq * 8);
            const bf16x8 qa0 = *(const LAS bf16x8*)(Qs + (16 * mt + fr) * P + fq * 8), qa1 = *(const LAS bf16x8*)(Qs + (16 * mt + fr) * P + 32 + fq * 8);
            const bf16x8 sb0 = *(const LAS bf16x8*)(Sc + fr * P + fq * 8), sb1 = *(const LAS bf16x8*)(Sc + fr * P + 32 + fq * 8);
            acc = __builtin_amdgcn_mfma_f32_16x16x32_bf16(aa0, vb0, acc, 0, 0, 0); acc = __builtin_amdgcn_mfma_f32_16x16x32_bf16(aa1, vb1, acc, 0, 0, 0);
            acc = __builtin_amdgcn_mfma_f32_16x16x32_bf16(qa0, sb0, acc, 0, 0, 0); acc = __builtin_amdgcn_mfma_f32_16x16x32_bf16(qa1, sb1, acc, 0, 0, 0);
#pragma unroll
            for (int j = 0; j < 4; ++j) Oraw[(mb + (size_t)c * 64 + 16 * mt + fq * 4 + j) * 512 + h * 128 + vs * 16 + fr] = (bf16)f2bf(acc[j]);
          } else { const int dt = wave - 4;
            const bf16x8 ka0 = *(const LAS bf16x8*)(Kdt + (16 * dt + fr) * P + fq * 8), ka1 = *(const LAS bf16x8*)(Kdt + (16 * dt + fr) * P + 32 + fq * 8);
            const f4 dc = *(const LAS f4*)(DEC + 16 * dt + fq * 4);
            Sacc[0] *= dc.x; Sacc[1] *= dc.y; Sacc[2] *= dc.z; Sacc[3] *= dc.w;
            Sacc = __builtin_amdgcn_mfma_f32_16x16x32_bf16(ka0, vb0, Sacc, 0, 0, 0); Sacc = __builtin_amdgcn_mfma_f32_16x16x32_bf16(ka1, vb1, Sacc, 0, 0, 0);
            *(LAS u2*)(Sn + fr * P + 16 * dt + fq * 4) = (u2){pk2(Sacc[0], Sacc[1]), pk2(Sacc[2], Sacc[3])}; } }
        __syncthreads();
        if (cc_ + 1 < NCH) GLA_STORE();
        __syncthreads();
    }
#undef GLA_LOAD
#undef GLA_STORE
}
__device__ __forceinline__ void p5_post(const Args& a) {
    const int tid = threadIdx.x, lane = tid & 63, wave = tid >> 6;
    const int gw = blockIdx.x * NWAVE + wave, NGW = gridDim.x * NWAVE;
    const bf16* __restrict__ RWP = (const bf16*)(a.ws + WS_RWP); const bf16* __restrict__ GLAP = (const bf16*)(a.ws + WS_GLAP);
    bf16* Yraw = (bf16*)(a.ws + WS_U); bf16* Oraw = (bf16*)(a.ws + WS_U + 16 * MiB);
    const bf16* __restrict__ G = (const bf16*)(a.out + (size_t)12 * MiB); const float* __restrict__ SB = (const float*)(a.ws + WS_SB);
    const float* mu = a.in[5]; const float* gng = a.in[14]; const float* gnb = a.in[15]; const float* nrm = a.in[18];
    const float ng0 = nrm[lane], ng1 = nrm[64 + lane];
    for (int m = gw; m < M; m += NGW) {
        const int t = m & 2047; const size_t mq = t ? (size_t)(m - 1) : (size_t)m;
        float y[8], vp[8], vq[8], g[8], sb[8], o0[4], o1[4], g0[4], g1[4];
#pragma unroll
        for (int h = 0; h < 8; ++h) { const int col = h * 64 + lane; y[h] = bf2f(Yraw[(size_t)m * 512 + col]); vp[h] = bf2f(RWP[(size_t)m * RWC + 1024 + col]); vq[h] = bf2f(RWP[mq * RWC + 1024 + col]);
            g[h] = bf2f(G[(size_t)m * 512 + col]); sb[h] = SB[(size_t)m * 8 + h]; }
#pragma unroll
        for (int h = 0; h < 4; ++h) { const int c0 = h * 128 + lane, c1 = c0 + 64; o0[h] = bf2f(Oraw[(size_t)m * 512 + c0]); o1[h] = bf2f(Oraw[(size_t)m * 512 + c1]);
            g0[h] = bf2f(GLAP[(size_t)m * GLCP + 1024 + c0]); g1[h] = bf2f(GLAP[(size_t)m * GLCP + 1024 + c1]); }
#pragma unroll
        for (int h = 0; h < 8; ++h) { const int col = h * 64 + lane;
            const float v = vp[h] + mu[1024 + col] * ((t ? vq[h] : 0.f) - vp[h]);
            float sm = reduce16(y[h]); sm += __shfl_xor(sm, 16); sm += __shfl_xor(sm, 32);
            const float mean = sm * (1.f / 64.f); const float dl = y[h] - mean; float sv = reduce16(dl * dl); sv += __shfl_xor(sv, 16); sv += __shfl_xor(sv, 32);
            const float yn = dl * rsqrtf(sv * (1.f / 64.f) + GN_EPS) * gng[col] + gnb[col];
            Yraw[(size_t)m * 512 + col] = (bf16)f2bf((yn + sb[h] * v) * g[h]); }
#pragma unroll
        for (int h = 0; h < 4; ++h) { const int c0 = h * 128 + lane, c1 = c0 + 64;
            float ms = reduce16(o0[h] * o0[h] + o1[h] * o1[h]); ms += __shfl_xor(ms, 16); ms += __shfl_xor(ms, 32);
            const float rs = rsqrtf(ms * (1.f / 128.f) + GLA_EPS);
            Oraw[(size_t)m * 512 + c0] = (bf16)f2bf(o0[h] * rs * ng0 * g0[h] * sigm(g0[h])); Oraw[(size_t)m * 512 + c1] = (bf16)f2bf(o1[h] * rs * ng1 * g1[h] * sigm(g1[h])); }
    }
}
__device__ __forceinline__ void ln_rows(float* X, const float* __restrict__ g, const float* __restrict__ bta, const float* __restrict__ MOD, bf16* __restrict__ U2) {
    const int tid = threadIdx.x, lane = tid & 63, wave = tid >> 6;
    const int gw = blockIdx.x * NWAVE + wave, NGW = gridDim.x * NWAVE;
    f4 gg[4], bb[4];
#pragma unroll
    for (int j = 0; j < 4; ++j) { gg[j] = ((const f4*)g)[lane + 64 * j]; bb[j] = ((const f4*)bta)[lane + 64 * j]; }
    for (int m = gw; m < M; m += NGW) {
        f4* xr = (f4*)(X + (size_t)m * D) + lane; f4 v[4], sh[4], sc[4]; float s = 0.f;
        const int b = m >> 11;
#pragma unroll
        for (int j = 0; j < 4; ++j) { v[j] = xr[64 * j]; s += (v[j].x + v[j].y) + (v[j].z + v[j].w); }
        if (U2) {
#pragma unroll
            for (int j = 0; j < 4; ++j) { sh[j] = ((const f4*)(MOD + b * 6144 + 3072))[lane + 64 * j]; sc[j] = ((const f4*)(MOD + b * 6144 + 4096))[lane + 64 * j]; } }
        float sm = reduce16(s); sm += __shfl_xor(sm, 16); sm += __shfl_xor(sm, 32);
        const float mean = sm * (1.f / D); float s2 = 0.f;
#pragma unroll
        for (int j = 0; j < 4; ++j) { v[j] = v[j] - mean; s2 += (v[j].x * v[j].x + v[j].y * v[j].y) + (v[j].z * v[j].z + v[j].w * v[j].w); }
        float sq = reduce16(s2); sq += __shfl_xor(sq, 16); sq += __shfl_xor(sq, 32);
        const float rstd = rsqrtf(sq * (1.f / D) + LN_EPS);
#pragma unroll
        for (int j = 0; j < 4; ++j) { const f4 r = v[j] * rstd * gg[j] + bb[j]; xr[64 * j] = r;
            if (U2) { const f4 uu = r * (sc[j] + 1.0f) + sh[j]; u2 w; w.x = pk2(uu.x, uu.y); w.y = pk2(uu.z, uu.w); ((u2*)(U2 + (size_t)m * D))[lane + 64 * j] = w; } }
    }
}

#ifndef REPMASK
#define REPMASK 0
#endif
#define PH_BEGIN(k) _Pragma("unroll") for (int rep_ = 0; rep_ < 1 + ((REPMASK >> (k)) & 1); ++rep_) {
#define PH_END() grid.sync(); }
__global__ void __launch_bounds__(NT, 2) fwd_mega(Args a) {
    extern __shared__ __attribute__((aligned(16))) unsigned char lds[];
    cg::grid_group grid = cg::this_grid();
    LAS unsigned char* L = (LAS unsigned char*)lds; LAS float* ldsf = (LAS float*)lds;
    unsigned char* ws = a.ws;
    float* MOD = (float*)(ws + WS_MOD);
    bf16* U = (bf16*)(ws + WS_U);
    const int G = gridDim.x;
    PH_BEGIN(0)
    p0_mod(a.in[1], a.in[2], a.in[3], MOD, ldsf);
    p0_weights(a, ldsf);
    PH_END()
    PH_BEGIN(1)
    p1_modulate(a.in[0], MOD, U);
    PH_END()
    PH_BEGIN(2)
    { pg8::Gemm g{U, (const bf16*)(ws + WS_WIN), M, NPROJ, D, U, 0}; pg8::StaticOrder S; S.init(M, NPROJ, G, (int)blockIdx.x);
      EpiProj E{(bf16*)(ws + WS_RWP), (bf16*)(ws + WS_GLAP), (bf16*)(ws + WS_GATES)};
      pg8::gemm_phase<EpiProj, pg8::StaticOrder, true, true>(L, g, S, E); }
    PH_END()
    PH_BEGIN(3)
    p3_lora(a, L);
    gla_pre(a, ldsf);
    PH_END()
    PH_BEGIN(4)
    for (int unit = blockIdx.x; unit < 256; unit += G) rw_scan_unit(a, ldsf, unit);
    __syncthreads();
    for (int unit = blockIdx.x; unit < 256; unit += G) gla_unit(a, L, unit);
    PH_END()
    PH_BEGIN(5)
    p5_post(a);
    PH_END()
    PH_BEGIN(6)
    { pg8::Gemm g{U, (const bf16*)(ws + WS_WBR), M, D, 512, (const bf16*)(ws + WS_U + 16 * MiB), 4}; pg8::TwoPartOrder S; S.init(M, D, G, (int)blockIdx.x);
      EpiGate E{(bf16*)(ws + WS_MG), (const bf16*)(ws + WS_GATES)};
      pg8::gemm_phase<EpiGate, pg8::TwoPartOrder, true, true>(L, g, S, E); }
    PH_END()
    PH_BEGIN(7)
    { pg8::Gemm g{(const bf16*)(ws + WS_MG), (const bf16*)(ws + WS_WMIX), M, D, D, (const bf16*)(ws + WS_MG), 0}; pg8::StaticOrder S; S.init(M, D, G, (int)blockIdx.x);
      EpiRes E{a.in[0], a.out, MOD + 2048};
      pg8::gemm_phase<EpiRes, pg8::StaticOrder, true, true>(L, g, S, E); }
    PH_END()
    PH_BEGIN(8)
    ln_rows(a.out, a.in[22], a.in[23], MOD, U);
    PH_END()
    PH_BEGIN(9)
    { pg8::Gemm g{U, (const bf16*)(ws + WS_W1), M, 2 * DFF, D, U, 0}; pg8::StaticOrder S; S.init(M, 2 * DFF, G, (int)blockIdx.x);
      EpiSwiGLU E{(bf16*)(ws + WS_H)};
      pg8::gemm_phase<EpiSwiGLU, pg8::StaticOrder, true, true>(L, g, S, E); }
    PH_END()
    PH_BEGIN(10)
    { pg8::Gemm g{(const bf16*)(ws + WS_H), (const bf16*)(ws + WS_W2), M, D, DFF, (const bf16*)(ws + WS_H), 0}; pg8::StaticOrder S; S.init(M, D, G, (int)blockIdx.x);
      EpiRes E{a.out, a.out, MOD + 5120};
      pg8::gemm_phase<EpiRes, pg8::StaticOrder, true, true>(L, g, S, E); }
    PH_END()
    PH_BEGIN(11)
    ln_rows(a.out, a.in[26], a.in[27], MOD, nullptr);
    }
}

extern "C" void kernel_launch(void* const* d_in, const int* in_sizes, int n_in, void* d_out, int out_size, void* d_ws, size_t ws_size, hipStream_t stream) {
    static int grid = 0;
    if (grid == 0) {
        int dev = 0, cus = 0, per_cu = 0;
        hipGetDevice(&dev);
        hipDeviceGetAttribute(&cus, hipDeviceAttributeMultiprocessorCount, dev);
        if (hipFuncSetAttribute((const void*)fwd_mega, hipFuncAttributeMaxDynamicSharedMemorySize, LDS_BYTES) != hipSuccess) fprintf(stderr, "hipFuncSetAttribute failed\n");
        if (hipOccupancyMaxActiveBlocksPerMultiprocessor(&per_cu, (const void*)fwd_mega, NT, LDS_BYTES) != hipSuccess || per_cu < 1) { fprintf(stderr, "occupancy query: %d\n", per_cu); per_cu = 1; }
        (void)hipGetLastError();
        grid = cus * 1;
        if (grid <= 0) grid = 256;
    }
    Args a{};
    for (int i = 0; i < 28; ++i) a.in[i] = (const float*)d_in[i];
    a.out = (float*)d_out; a.ws = (unsigned char*)d_ws;
    void* args[] = {&a};
    hipError_t e = hipLaunchCooperativeKernel((const void*)fwd_mega, dim3(grid), dim3(NT), args, LDS_BYTES, stream);
    if (e != hipSuccess) fprintf(stderr, "cooperative launch failed: %s (grid %d)\n", hipGetErrorString(e), grid);
}
```

```cpp
#include <hip/hip_runtime.h>
#include <hip/hip_cooperative_groups.h>
#include <cstdio>
#include <cstdint>
namespace cg = cooperative_groups;
namespace pg8 {
#define PG8_LAS __attribute__((address_space(3)))
typedef unsigned short bf16_t;
typedef short bf16x8 __attribute__((ext_vector_type(8)));
typedef float f32x4 __attribute__((ext_vector_type(4)));
typedef unsigned u32x4 __attribute__((ext_vector_type(4)));
constexpr int BM = 256, BK = 64, HALF = 128, HTB = HALF * BK * 2  , STAGE_BYTES = 8 * HTB, NXCD = 8, WGM = 8;

__host__ __device__ __forceinline__ int lds_byte(int r, int c) { const int st = (r >> 4) * 2 + (c >> 5), rr = r & 15, cc = c & 31, ob = rr * 64 + cc * 2; return st * 1024 + (ob ^ (((ob >> 9) & 1) << 5)); }
__host__ __device__ __forceinline__ void stage_rc(int b, int& R, int& C) { const int st = b / 1024, sb = b % 1024, swz = sb ^ (((sb >> 9) & 1) << 5); R = (st >> 1) * 16 + swz / 64; C = (st & 1) * 32 + (swz % 64) / 2; }
__host__ __device__ __forceinline__ int perm32(int rho) { const int n = rho >> 4, i = rho & 15; return 8 * (i >> 2) + 4 * n + (i & 3); }

struct Unit { int pm, pn, part; };
struct Gemm { const bf16_t* A; const bf16_t* Bt; int M, N, K; const bf16_t* A2; int bpart; };

struct StaticOrder {
    int nM, nN, nwg, G, c;
    __host__ __device__ void init(int M, int N, int G_, int c_) { nM = M / BM; nN = N / BM; nwg = nM * nN; G = G_; c = c_; }
    __host__ __device__ bool next(int i, Unit& u) const {
        const long L = (long)i * G + c; if (L >= nwg) return false;
        int wgid = (int)L; { const int q = nwg / NXCD, r = nwg % NXCD, xcd = wgid % NXCD, off = wgid / NXCD; wgid = (xcd < r ? xcd * (q + 1) : r * (q + 1) + (xcd - r) * q) + off; }
        const int nig = WGM * nN, gid = wgid / nig, fm = gid * WGM, gsz = (nM - fm) < WGM ? (nM - fm) : WGM;
        u.pm = fm + ((wgid % nig) % gsz); u.pn = (wgid % nig) / gsz; u.part = 0; return true;
    }
    __device__ __forceinline__ void a_ready(const Unit&) const {}
    __device__ __forceinline__ void done(const Unit&) const {}
};

struct TwoPartOrder {
    StaticOrder S;
    __host__ __device__ void init(int M, int N, int G_, int c_) { S.init(M, N, G_, c_); }
    __host__ __device__ bool next(int i, Unit& u) const { if (!S.next(i >> 1, u)) return false; u.part = i & 1; return true; }
    __device__ __forceinline__ void a_ready(const Unit&) const {}
    __device__ __forceinline__ void done(const Unit&) const {}
};
__device__ __forceinline__ unsigned cvt_pk_bf16(float lo, float hi) { unsigned r; asm volatile("v_cvt_pk_bf16_f32 %0, %1, %2" : "=v"(r) : "v"(lo), "v"(hi)); return r; }
typedef float f32x2 __attribute__((ext_vector_type(2)));
template <class Epi, class Sched, bool ALIGN_EPI = false, bool SP2 = false>
__device__ __forceinline__ void gemm_phase(PG8_LAS unsigned char* lds, const Gemm g, const Sched& S, const Epi& E) {
    const int tid = threadIdx.x, wid = __builtin_amdgcn_readfirstlane(tid >> 6), lane = tid & 63, wr = wid >> 2, wc = wid & 3, fr = lane & 15, fq = lane >> 4;
    const int K = g.K, nt = K / BK;
    unsigned voffA[2], voffB[2];
#pragma unroll
    for (int i = 0; i < 2; ++i) { int R, C; stage_rc(tid * 16 + i * 8192, R, C); const int Rb = Epi::PERM ? ((R & ~31) + perm32(R & 31)) : R;
        voffA[i] = (unsigned)(R * K + C) * 2u; voffB[i] = (unsigned)(Rb * K + C) * 2u; }
    const size_t kstep = (size_t)(BK * 2);
    const size_t hstep = (size_t)HALF * K * 2;
    const size_t tstep = 2 * hstep;
    const unsigned ldsw = (unsigned)wid * 1024u;
    const int aoff = lds_byte(wr * 64 + fr, fq * 8), boff = lds_byte(wc * 32 + fr, fq * 8);
#define PG8_SA(b, h) (((b) * 2 + (h)) * HTB)
#define PG8_SB(b, h) ((4 + (b) * 2 + (h)) * HTB)
#define PG8_STAGE(bufoff, gbase, voff) do { _Pragma("unroll") for (int _i = 0; _i < 2; ++_i) \
        __builtin_amdgcn_global_load_lds((const unsigned*)((const char*)(gbase) + (voff)[_i]), (PG8_LAS unsigned*)(lds + (bufoff) + ldsw + _i * 8192), 16, 0, 0); } while (0)
#define PG8_LDA(dst, b, h) do { _Pragma("unroll") for (int m = 0; m < 4; ++m) _Pragma("unroll") for (int k = 0; k < 2; ++k) dst[m][k] = *(const PG8_LAS bf16x8*)(lds + PG8_SA(b, h) + aoff + m * 2048 + k * 1024); } while (0)
#define PG8_LDB(dst, b, h) do { _Pragma("unroll") for (int n = 0; n < 2; ++n) _Pragma("unroll") for (int k = 0; k < 2; ++k) dst[n][k] = *(const PG8_LAS bf16x8*)(lds + PG8_SB(b, h) + boff + n * 2048 + k * 1024); } while (0)
#define PG8_MMA(ai, bj, At, Bt) do { __builtin_amdgcn_s_setprio(1); _Pragma("unroll") for (int m = 0; m < 4; ++m) _Pragma("unroll") for (int n = 0; n < 2; ++n) _Pragma("unroll") for (int k = 0; k < 2; ++k) \
        acc[ai][bj][m][n] = __builtin_amdgcn_mfma_f32_16x16x32_bf16(Bt[n][k], At[m][k], acc[ai][bj][m][n], 0, 0, 0); __builtin_amdgcn_s_setprio(0); } while (0)
#define PG8_WAIT_V(n) asm volatile("s_waitcnt vmcnt(" #n ")" ::: "memory")
#define PG8_WAIT_L(n) asm volatile("s_waitcnt lgkmcnt(" #n ")" ::: "memory")
#define PG8_BAR __builtin_amdgcn_s_barrier()
#define PG8_SCHED __builtin_amdgcn_sched_barrier(0)
    Unit cur, nxt; int ui = 0;
    if (!S.next(0, cur)) return;
    f32x4 acc[2][2][4][2];
#pragma unroll
    for (int a = 0; a < 2; ++a)
#pragma unroll
        for (int b = 0; b < 2; ++b)
#pragma unroll
            for (int m = 0; m < 4; ++m)
#pragma unroll
                for (int n = 0; n < 2; ++n) acc[a][b][m][n] = (f32x4){0.f, 0.f, 0.f, 0.f};
    bf16x8 At[4][2], B0[2][2], B1[2][2];
    const char* cA = (const char*)(cur.part ? g.A2 : g.A) + (size_t)cur.pm * tstep; const char* cB = (const char*)g.Bt + (size_t)(cur.pn + cur.part * g.bpart) * tstep;
    S.a_ready(cur);
    if constexpr (SP2) {
        PG8_STAGE(PG8_SB(0, 0), cB, voffB); PG8_STAGE(PG8_SB(0, 1), cB + hstep, voffB); PG8_STAGE(PG8_SA(0, 0), cA, voffA); PG8_STAGE(PG8_SA(0, 1), cA + hstep, voffA);
        if (wr == 1) PG8_BAR;
        PG8_WAIT_V(2); PG8_BAR;
        PG8_STAGE(PG8_SB(1, 0), cB + kstep, voffB); PG8_STAGE(PG8_SA(1, 0), cA + kstep, voffA); PG8_STAGE(PG8_SB(1, 1), cB + hstep + kstep, voffB);
        PG8_WAIT_V(6); PG8_BAR;
    } else {
        PG8_STAGE(PG8_SB(0, 0), cB, voffB); PG8_STAGE(PG8_SA(0, 0), cA, voffA); PG8_STAGE(PG8_SB(0, 1), cB + hstep, voffB); PG8_STAGE(PG8_SA(0, 1), cA + hstep, voffA);
        if (wr == 1) PG8_BAR;
        PG8_WAIT_V(4); PG8_BAR;
        PG8_STAGE(PG8_SB(1, 0), cB + kstep, voffB); PG8_STAGE(PG8_SA(1, 0), cA + kstep, voffA); PG8_STAGE(PG8_SB(1, 1), cB + hstep + kstep, voffB);
        PG8_WAIT_V(6); PG8_BAR;
    }
    for (;;) {
        const bool has_next = S.next(ui + 1, nxt);
        const char* nA = has_next ? (const char*)(nxt.part ? g.A2 : g.A) + (size_t)nxt.pm * tstep : cA; const char* nB = has_next ? (const char*)g.Bt + (size_t)(nxt.pn + nxt.part * g.bpart) * tstep : cB;
        for (int t = 0; t < nt; t += 2) {
            const bool last = (t == nt - 2);
            const char* a1 = cA + (size_t)(t + 1) * kstep;
            const char* a2 = last ? nA : cA + (size_t)(t + 2) * kstep; const char* b2 = last ? nB : cB + (size_t)(t + 2) * kstep;
            const char* a3 = a2 + kstep; const char* b3 = b2 + kstep;
            if (last && has_next) S.a_ready(nxt);
            if constexpr (SP2) {
            PG8_LDB(B0, 0, 0); PG8_LDB(B1, 0, 1); PG8_SCHED; PG8_LDA(At, 0, 0); PG8_STAGE(PG8_SA(1, 1), a1 + hstep, voffA);
            PG8_WAIT_V(8); PG8_WAIT_L(0); PG8_BAR; PG8_MMA(0, 0, At, B0); PG8_MMA(0, 1, At, B1); PG8_BAR; PG8_SCHED;
            PG8_LDA(At, 0, 1); PG8_STAGE(PG8_SB(0, 0), b2, voffB); PG8_STAGE(PG8_SB(0, 1), b2 + hstep, voffB); PG8_STAGE(PG8_SA(0, 0), a2, voffA);
            PG8_WAIT_V(8); PG8_WAIT_L(0); PG8_BAR; PG8_MMA(1, 0, At, B0); PG8_MMA(1, 1, At, B1); PG8_BAR; PG8_SCHED;
            PG8_LDB(B0, 1, 0); PG8_LDB(B1, 1, 1); PG8_SCHED; PG8_LDA(At, 1, 0); PG8_STAGE(PG8_SA(0, 1), a2 + hstep, voffA);
            PG8_WAIT_V(8); PG8_WAIT_L(0); PG8_BAR; PG8_MMA(0, 0, At, B0); PG8_MMA(0, 1, At, B1); PG8_BAR; PG8_SCHED;
            PG8_LDA(At, 1, 1); PG8_STAGE(PG8_SB(1, 0), b3, voffB); PG8_STAGE(PG8_SB(1, 1), b3 + hstep, voffB); PG8_STAGE(PG8_SA(1, 0), a3, voffA);
            PG8_WAIT_V(8); PG8_WAIT_L(0); PG8_BAR; PG8_MMA(1, 0, At, B0); PG8_MMA(1, 1, At, B1); PG8_BAR; PG8_SCHED;
            } else {
            PG8_LDB(B0, 0, 0); PG8_SCHED; PG8_LDA(At, 0, 0); PG8_STAGE(PG8_SA(1, 1), a1 + hstep, voffA);
            PG8_WAIT_L(8); PG8_BAR; PG8_WAIT_L(0); PG8_MMA(0, 0, At, B0); PG8_BAR; PG8_SCHED;
            PG8_LDB(B1, 0, 1); PG8_STAGE(PG8_SB(0, 0), b2, voffB);
            PG8_BAR; PG8_WAIT_L(0); PG8_MMA(0, 1, At, B1); PG8_BAR;
            PG8_LDA(At, 0, 1); PG8_STAGE(PG8_SA(0, 0), a2, voffA);
            PG8_BAR; PG8_WAIT_L(0); PG8_MMA(1, 0, At, B0); PG8_BAR; PG8_SCHED;
            PG8_STAGE(PG8_SB(0, 1), b2 + hstep, voffB);
            PG8_WAIT_V(6); PG8_BAR; PG8_MMA(1, 1, At, B1); PG8_BAR;
            PG8_LDB(B0, 1, 0); PG8_SCHED; PG8_LDA(At, 1, 0); PG8_STAGE(PG8_SA(0, 1), a2 + hstep, voffA);
            PG8_WAIT_L(8); PG8_BAR; PG8_WAIT_L(0); PG8_MMA(0, 0, At, B0); PG8_BAR; PG8_SCHED;
            PG8_LDB(B1, 1, 1); PG8_STAGE(PG8_SB(1, 0), b3, voffB);
            PG8_BAR; PG8_WAIT_L(0); PG8_MMA(0, 1, At, B1); PG8_BAR;
            PG8_LDA(At, 1, 1); PG8_STAGE(PG8_SA(1, 0), a3, voffA);
            PG8_BAR; PG8_WAIT_L(0); PG8_MMA(1, 0, At, B0); PG8_BAR; PG8_SCHED;
            PG8_STAGE(PG8_SB(1, 1), b3 + hstep, voffB);
            PG8_WAIT_V(6); PG8_BAR; PG8_MMA(1, 1, At, B1); PG8_BAR;
            }
        }
        if constexpr (ALIGN_EPI) { if (wr == 0) PG8_BAR; }
        bool midp = false; if constexpr (Epi::TWO_PART) midp = (cur.part == 0);
        if constexpr (Epi::TWO_PART) { if (midp) E.mid(acc, cur, wr, wc, fr, fq); else E(acc, cur, wr, wc, fr, fq); } else { E(acc, cur, wr, wc, fr, fq); }
        if (!has_next) break;
        if (!midp) {
#pragma unroll
        for (int a = 0; a < 2; ++a)
#pragma unroll
            for (int b = 0; b < 2; ++b)
#pragma unroll
                for (int m = 0; m < 4; ++m)
#pragma unroll
                    for (int n = 0; n < 2; ++n) acc[a][b][m][n] = (f32x4){0.f, 0.f, 0.f, 0.f};
        }
        cur = nxt; cA = nA; cB = nB; ++ui;
        if constexpr (ALIGN_EPI) { if (wr == 1) PG8_BAR; }
    }
    PG8_WAIT_V(0);
    if constexpr (!ALIGN_EPI) { if (wr == 0) PG8_BAR; }
    PG8_BAR;
    if constexpr (Epi::AFTER_DRAIN) { E.fused(acc, cur, wr, wc, fr, fq, lds, wid, lane); S.done(cur); }
#undef PG8_SA
#undef PG8_SB
#undef PG8_STAGE
#undef PG8_LDA
#undef PG8_LDB
#undef PG8_MMA
#undef PG8_WAIT_V
#undef PG8_WAIT_L
#undef PG8_BAR
#undef PG8_SCHED
}
}
#ifndef REP_RW
#define REP_RW 1
#endif
#ifndef REP_GLA
#define REP_GLA 1
#endif

#define LAS __attribute__((address_space(3)))
typedef unsigned short bf16;
typedef float f4 __attribute__((ext_vector_type(4)));
typedef float f2 __attribute__((ext_vector_type(2)));
typedef unsigned u4 __attribute__((ext_vector_type(4)));
typedef unsigned u2 __attribute__((ext_vector_type(2)));

constexpr int NT = 512, NWAVE = 8;
constexpr int D = 1024, NBATCH = 8, SEQ = 2048, M = NBATCH * SEQ;
constexpr int RWC = 1792, GLCP = 1792, NGATE = 2048, NPROJ = 5632, NIN = 5392, DFF = 2816;
constexpr float ALPHA = 1.189207115002721f, LN_EPS = 1e-5f, GN_EPS = 64e-5f, GLA_EPS = 1e-5f;
constexpr int LDS_BYTES = 147456;

constexpr size_t MiB = 1u << 20;
constexpr size_t WS_MOD = 0, WS_BAR = 256 * 1024, WS_SB = 1 * MiB, WS_WIN = 2 * MiB, WS_W1 = 13 * MiB, WS_W2 = 24 * MiB, WS_WBR = 30 * MiB, WS_WMIX = 32 * MiB,
                 WS_U = 36 * MiB, WS_RWP = 68 * MiB, WS_GLAP = 124 * MiB, WS_GATES = 180 * MiB, WS_MG = 68 * MiB, WS_H = 68 * MiB,
                 WS_DECG = 1 * MiB + 512 * 1024, WS_W2T = 1 * MiB + 768 * 1024, WS_A2T = WS_W2T + 65536, WS_G2T = WS_A2T + 65536, WS_KDT = 244 * MiB, WS_INVN = 252 * MiB;

__device__ __forceinline__ unsigned f2bf(float f) { unsigned u = __builtin_bit_cast(unsigned, f); return (u + 0x7fffu + ((u >> 16) & 1u)) >> 16; }
__device__ __forceinline__ unsigned pk2(float lo, float hi) { return f2bf(lo) | (f2bf(hi) << 16); }
__device__ __forceinline__ float bf2f(unsigned short b) { return __builtin_bit_cast(float, ((unsigned)b) << 16); }
__device__ __forceinline__ float bflo(unsigned w) { return __builtin_bit_cast(float, w << 16); }
__device__ __forceinline__ float bfhi(unsigned w) { return __builtin_bit_cast(float, w & 0xffff0000u); }
__device__ __forceinline__ float sigm(float x) { return 1.f / (1.f + __expf(-x)); }
__device__ __forceinline__ float wave_sum(float v) {
#pragma unroll
    for (int o = 1; o < 64; o <<= 1) v += __shfl_xor(v, o);
    return v;
}
template <int CTRL> __device__ __forceinline__ float dppf(float x) { return __builtin_bit_cast(float, __builtin_amdgcn_mov_dpp(__builtin_bit_cast(int, x), CTRL, 0xf, 0xf, true)); }
__device__ __forceinline__ float reduce16(float x) { x += dppf<0xB1>(x); x += dppf<0x4E>(x); x += dppf<0x141>(x); x += dppf<0x128>(x); return x; }
#define LDS_WAIT() asm volatile("s_waitcnt lgkmcnt(0)" ::: "memory")


#define XB_TMO      128
#define XB_XCNT(j)  (256  + 64 * (j))
#define XB_XSUB(j)  (1280 + 64 * (j))
#define XB_XGEN(j)  (2304 + 64 * (j))
#define XB_TOP      3328
#define XB_TOPGEN   3392
#define XCD_BAR_WORDS 3456
#define XB_SPIN_CAP (1u << 18)

__device__ __forceinline__ unsigned xb_ld(unsigned* p)              { return __hip_atomic_load(p, __ATOMIC_RELAXED, __HIP_MEMORY_SCOPE_AGENT); }
__device__ __forceinline__ unsigned xb_add(unsigned* p, unsigned v) { return __hip_atomic_fetch_add(p, v, __ATOMIC_RELAXED, __HIP_MEMORY_SCOPE_AGENT); }
__device__ __forceinline__ unsigned xb_xcc_id() { return (unsigned)__builtin_amdgcn_s_getreg((3 << 11) | 20) & 0xFu; }
#define XB_SPIN(cond, bar) do { unsigned _sp = 0; while (cond) { __builtin_amdgcn_s_sleep(1); \
    if ((++_sp & 255u) == 0u) { if (xb_ld(&(bar)[XB_TMO])) break; if (_sp > XB_SPIN_CAP) { atomicAdd(&(bar)[XB_TMO], 1u); break; } } } } while (0)

struct XcdBarrier {
    unsigned* bar; unsigned x;
    volatile LAS unsigned* st;
};

__device__ __forceinline__ XcdBarrier xcd_barrier_post(unsigned* bar, volatile LAS unsigned* st) {
    XcdBarrier b; b.bar = bar; b.x = xb_xcc_id(); b.st = st;
    if (threadIdx.x == 0) (void)xb_add(&bar[XB_XCNT(b.x)], 1u);
    return b;
}
__device__ __forceinline__ void xcd_barrier_complete(unsigned* bar, unsigned x, unsigned& nloc, unsigned& nx) {
    const unsigned G = gridDim.x * gridDim.y * gridDim.z;
    unsigned sum, cnt, mine, sp = 0u;
    for (;;) {
        sum = 0u; cnt = 0u; mine = 0u;
#pragma unroll
        for (unsigned j = 0; j < 16; ++j) { const unsigned c = xb_ld(&bar[XB_XCNT(j)]); sum += c; cnt += (c > 0u) ? 1u : 0u; mine = (j == x) ? c : mine; }
        if (sum == G) break;
        __builtin_amdgcn_s_sleep(1);
        if ((++sp & 255u) == 0u) { if (xb_ld(&bar[XB_TMO])) break; if (sp > XB_SPIN_CAP) { atomicAdd(&bar[XB_TMO], 1u); break; } }
    }
    nloc = mine > 0u ? mine : 1u; nx = cnt > 0u ? cnt : 1u;
}

__device__ __forceinline__ void xcd_barrier(const XcdBarrier& b) {
    asm volatile("s_waitcnt vmcnt(0)" ::: "memory");
    __syncthreads();
    if (threadIdx.x == 0) {
        unsigned* bar = b.bar;
        __builtin_amdgcn_s_waitcnt(0);
        unsigned nloc = b.st[0], nx = b.st[1];
        if (nloc == 0u) { xcd_barrier_complete(bar, b.x, nloc, nx); b.st[0] = nloc; b.st[1] = nx; }
        const unsigned old = xb_add(&bar[XB_XSUB(b.x)], 1u);
        const unsigned gen = old / nloc;
        if (old + 1u == (gen + 1u) * nloc) {
            __builtin_amdgcn_fence(__ATOMIC_RELEASE, "agent");
            asm volatile("s_waitcnt vmcnt(0)" ::: "memory");
            const unsigned og = xb_add(&bar[XB_TOP], 1u);
            const unsigned tg = og / nx;
            if (og + 1u == (tg + 1u) * nx) xb_add(&bar[XB_TOPGEN], 1u);
            else XB_SPIN(xb_ld(&bar[XB_TOPGEN]) == tg, bar);
            __builtin_amdgcn_fence(__ATOMIC_ACQUIRE, "agent");
            xb_add(&bar[XB_XGEN(b.x)], 1u);
            asm volatile("s_waitcnt vmcnt(0)" ::: "memory");
        } else {
            XB_SPIN(xb_ld(&bar[XB_XGEN(b.x)]) == gen, bar);
            __builtin_amdgcn_fence(__ATOMIC_ACQUIRE, "agent");
            asm volatile("s_waitcnt vmcnt(0)" ::: "memory");
        }
    }
    __syncthreads();
}


struct Args { const float* in[28]; float* out; unsigned char* ws; };

struct EpiProj {
    static constexpr bool PERM = true, AFTER_DRAIN = false, TWO_PART = false;
    bf16 *RWP, *GLAP, *GATES;
    __device__ __forceinline__ void operator()(const pg8::f32x4 (&acc)[2][2][4][2], const pg8::Unit& u, int wr, int wc, int fr, int fq) const {
        bf16* base; int ldc, colt; bool sg;
        if (u.pn < 7) { base = RWP; ldc = RWC; colt = u.pn * 256; sg = false; }
        else if (u.pn < 14) { base = GLAP; ldc = GLCP; colt = (u.pn - 7) * 256; sg = false; }
        else { base = GATES; ldc = NGATE; colt = (u.pn - 14) * 256; sg = true; }
        const int row0 = u.pm * 256 + wr * 64 + fr, col0 = colt + wc * 32 + 8 * fq;
#pragma unroll
        for (int ai = 0; ai < 2; ++ai)
#pragma unroll
            for (int m = 0; m < 4; ++m) { bf16* rowp = base + (size_t)(row0 + ai * 128 + m * 16) * ldc + col0;
#pragma unroll
                for (int bj = 0; bj < 2; ++bj) { pg8::f32x4 v0 = acc[ai][bj][m][0], v1 = acc[ai][bj][m][1];
                    if (sg) {
#pragma unroll
                        for (int j = 0; j < 4; ++j) { v0[j] = sigm(v0[j]); v1[j] = sigm(v1[j]); } }
                    u4 w; w.x = pk2(v0[0], v0[1]); w.y = pk2(v0[2], v0[3]); w.z = pk2(v1[0], v1[1]); w.w = pk2(v1[2], v1[3]);
                    *(u4*)(rowp + bj * 128) = w; } }
    }
};
struct EpiGate {
    static constexpr bool PERM = true, AFTER_DRAIN = false, TWO_PART = true;
    bf16* MG; const bf16* GATES;
    __device__ __forceinline__ void mid(pg8::f32x4 (&acc)[2][2][4][2], const pg8::Unit& u, int wr, int wc, int fr, int fq) const {
        const int row0 = u.pm * 256 + wr * 64 + fr, col0 = u.pn * 256 + wc * 32 + 8 * fq;
#pragma unroll
        for (int ai = 0; ai < 2; ++ai)
#pragma unroll
            for (int m = 0; m < 4; ++m) { const size_t off = (size_t)(row0 + ai * 128 + m * 16) * NGATE + col0;
#pragma unroll
                for (int bj = 0; bj < 2; ++bj) { const u4 ga = *(const u4*)(GATES + off + bj * 128), gb = *(const u4*)(GATES + off + 1024 + bj * 128);
                    acc[ai][bj][m][0][0] *= bflo(ga.x) / bflo(gb.x); acc[ai][bj][m][0][1] *= bfhi(ga.x) / bfhi(gb.x); acc[ai][bj][m][0][2] *= bflo(ga.y) / bflo(gb.y); acc[ai][bj][m][0][3] *= bfhi(ga.y) / bfhi(gb.y);
                    acc[ai][bj][m][1][0] *= bflo(ga.z) / bflo(gb.z); acc[ai][bj][m][1][1] *= bfhi(ga.z) / bfhi(gb.z); acc[ai][bj][m][1][2] *= bflo(ga.w) / bflo(gb.w); acc[ai][bj][m][1][3] *= bfhi(ga.w) / bfhi(gb.w); } }
    }
    __device__ __forceinline__ void operator()(const pg8::f32x4 (&acc)[2][2][4][2], const pg8::Unit& u, int wr, int wc, int fr, int fq) const {
        const int row0 = u.pm * 256 + wr * 64 + fr, col0 = u.pn * 256 + wc * 32 + 8 * fq;
#pragma unroll
        for (int ai = 0; ai < 2; ++ai)
#pragma unroll
            for (int m = 0; m < 4; ++m) { const int row = row0 + ai * 128 + m * 16;
#pragma unroll
                for (int bj = 0; bj < 2; ++bj) { const pg8::f32x4 v0 = acc[ai][bj][m][0], v1 = acc[ai][bj][m][1];
                    const u4 gt = *(const u4*)(GATES + (size_t)row * NGATE + 1024 + col0 + bj * 128);
                    u4 w; w.x = pk2(v0[0] * bflo(gt.x), v0[1] * bfhi(gt.x)); w.y = pk2(v0[2] * bflo(gt.y), v0[3] * bfhi(gt.y));
                    w.z = pk2(v1[0] * bflo(gt.z), v1[1] * bfhi(gt.z)); w.w = pk2(v1[2] * bflo(gt.w), v1[3] * bfhi(gt.w));
                    *(u4*)(MG + (size_t)row * D + col0 + bj * 128) = w; } }
    }
};
struct EpiRes {
    static constexpr bool PERM = false, AFTER_DRAIN = false, TWO_PART = false;
    const float* base; float* out; const float* gate;
    __device__ __forceinline__ void operator()(const pg8::f32x4 (&acc)[2][2][4][2], const pg8::Unit& u, int wr, int wc, int fr, int fq) const {
        const int row0 = u.pm * 256 + wr * 64 + fr, col0 = u.pn * 256 + wc * 32 + 4 * fq;
        const float* gp = gate + (size_t)(u.pm >> 3) * 6144 + col0;
        pg8::f32x4 gv[2][2];
#pragma unroll
        for (int bj = 0; bj < 2; ++bj)
#pragma unroll
            for (int n = 0; n < 2; ++n) gv[bj][n] = *(const pg8::f32x4*)(gp + bj * 128 + n * 16);
#pragma unroll
        for (int ai = 0; ai < 2; ++ai)
#pragma unroll
            for (int m = 0; m < 4; ++m) { const size_t off = (size_t)(row0 + ai * 128 + m * 16) * D + col0;
#pragma unroll
                for (int bj = 0; bj < 2; ++bj)
#pragma unroll
                    for (int n = 0; n < 2; ++n) { const pg8::f32x4 bs = *(const pg8::f32x4*)(base + off + bj * 128 + n * 16);
                        *(pg8::f32x4*)(out + off + bj * 128 + n * 16) = bs * ALPHA + gv[bj][n] * acc[ai][bj][m][n]; } }
    }
};
struct EpiSwiGLU {
    static constexpr bool PERM = true, AFTER_DRAIN = false, TWO_PART = false;
    bf16* H;
    __device__ __forceinline__ void operator()(const pg8::f32x4 (&acc)[2][2][4][2], const pg8::Unit& u, int wr, int wc, int fr, int fq) const {
        const int row0 = u.pm * 256 + wr * 64 + fr, col0 = u.pn * 128 + wc * 32 + 8 * fq;
#pragma unroll
        for (int ai = 0; ai < 2; ++ai)
#pragma unroll
            for (int m = 0; m < 4; ++m) { bf16* rowp = H + (size_t)(row0 + ai * 128 + m * 16) * DFF + col0;
                float h[8];
#pragma unroll
                for (int n = 0; n < 2; ++n)
#pragma unroll
                    for (int j = 0; j < 4; ++j) { const float g = acc[ai][0][m][n][j], up = acc[ai][1][m][n][j]; h[n * 4 + j] = g * sigm(g) * up; }
                u4 w; w.x = pk2(h[0], h[1]); w.y = pk2(h[2], h[3]); w.z = pk2(h[4], h[5]); w.w = pk2(h[6], h[7]);
                *(u4*)rowp = w; }
    }
};

__device__ __forceinline__ void p0_mod(const float* c, const float* w_ada, const float* b_ada, float* MOD, LAS float* ldsf) {
    const int tid = threadIdx.x;
    for (int cb = blockIdx.x; cb < 192; cb += gridDim.x) {
        LAS float* sc = ldsf; LAS float* red = ldsf + 8192;
        for (int i = tid; i < 8192; i += NT) { const float v = c[i]; sc[i] = v * sigm(v); }
        __syncthreads();
        const int cc = tid & 31, kp = tid >> 5, j = cb * 32 + cc;
        float acc[8];
#pragma unroll
        for (int b = 0; b < 8; ++b) acc[b] = 0.f;
#pragma unroll
        for (int hh = 0; hh < 2; ++hh) { float wv[32];
#pragma unroll
            for (int i = 0; i < 32; ++i) wv[i] = w_ada[(size_t)(kp + 16 * (hh * 32 + i)) * 6144 + j];
#pragma unroll
            for (int i = 0; i < 32; ++i) { const int k = kp + 16 * (hh * 32 + i);
#pragma unroll
                for (int b = 0; b < 8; ++b) acc[b] += sc[b * 1024 + k] * wv[i]; } }
#pragma unroll
        for (int b = 0; b < 8; ++b) red[(kp * 8 + b) * 32 + cc] = acc[b];
        __syncthreads();
        if (tid < 256) { const int b = tid >> 5; float s = 0.f;
#pragma unroll
            for (int q = 0; q < 16; ++q) s += red[(q * 8 + b) * 32 + cc];
            MOD[b * 6144 + j] = s + b_ada[j]; }
        __syncthreads();
    }
}
__device__ __forceinline__ int rowmap(int mode, int n) {
    if (mode == 1) return n < 3344 ? n : n + 240;
    if (mode == 2) { const int j = n < 2816 ? n : n - 2816; return (j >> 7) * 256 + (n < 2816 ? 0 : 128) + (j & 127); }
    return n;
}
__device__ __forceinline__ void tr_item(const float* W, int K, int N, bf16* WT, int ldt, int koff, int row_off, int mode, LAS float* scr, int item, int lane) {
    const int nblk = (N + 31) / 32, kb = item / nblk, nb = item % nblk, k0 = 64 * kb, n0 = 32 * nb;
    const int ncol = n0 + (lane & 31); const bool okc = ncol < N;
    float tv[32];
#pragma unroll
    for (int i = 0; i < 32; ++i) { const int kk = 2 * i + (lane >> 5); tv[i] = okc ? W[(size_t)(k0 + kk) * N + ncol] : 0.f; }
#pragma unroll
    for (int i = 0; i < 32; ++i) { const int kk = 2 * i + (lane >> 5); scr[kk * 33 + (lane & 31)] = tv[i]; }
    LDS_WAIT();
    const int c = lane & 7;
#pragma unroll
    for (int j = 0; j < 4; ++j) { const int n = (lane >> 3) + 8 * j; const LAS float* s = scr + (8 * c) * 33 + n;
        u4 o; o.x = pk2(s[0 * 33], s[1 * 33]); o.y = pk2(s[2 * 33], s[3 * 33]); o.z = pk2(s[4 * 33], s[5 * 33]); o.w = pk2(s[6 * 33], s[7 * 33]);
        if (n0 + n < N) *(u4*)(WT + (size_t)(rowmap(mode, n0 + n) + row_off) * ldt + koff + k0 + 8 * c) = o; }
    LDS_WAIT();
}
__device__ __forceinline__ void p0_weights(const Args& a, LAS float* ldsf) {
    const int tid = threadIdx.x, lane = tid & 63, wave = tid >> 6;
    LAS float* scr = ldsf + wave * 4096;
    const int gw = blockIdx.x * NWAVE + wave, NGW = gridDim.x * NWAVE;
    bf16* WinT = (bf16*)(a.ws + WS_WIN); bf16* W1T = (bf16*)(a.ws + WS_W1); bf16* W2T = (bf16*)(a.ws + WS_W2); bf16* WbrT = (bf16*)(a.ws + WS_WBR); bf16* WmixT = (bf16*)(a.ws + WS_WMIX);
    constexpr int I_IN = 16 * 169, I_F1 = 16 * 176, I_F2 = 44 * 32, I_BR = 8 * 32, I_MX = 16 * 32, I_L1 = 16, I_L2 = 32;
    constexpr int NITEMS = I_IN + I_F1 + I_F2 + 2 * I_BR + I_MX + 2 * I_L1 + I_L2;
    for (int it = gw; it < NITEMS; it += NGW) {
        int r = it;
        if (r < I_IN) { tr_item(a.in[4], 1024, NIN, WinT, 1024, 0, 0, 1, scr, r, lane); continue; } r -= I_IN;
        if (r < I_F1) { tr_item(a.in[24], 1024, 2 * DFF, W1T, 1024, 0, 0, 2, scr, r, lane); continue; } r -= I_F1;
        if (r < I_F2) { tr_item(a.in[25], DFF, 1024, W2T, DFF, 0, 0, 0, scr, r, lane); continue; } r -= I_F2;
        if (r < I_BR) { tr_item(a.in[19], 512, 1024, WbrT, 512, 0, 0, 0, scr, r, lane); continue; } r -= I_BR;
        if (r < I_BR) { tr_item(a.in[20], 512, 1024, WbrT, 512, 0, 1024, 0, scr, r, lane); continue; } r -= I_BR;
        if (r < I_MX) { tr_item(a.in[21], 1024, 1024, WmixT, 1024, 0, 0, 0, scr, r, lane); continue; } r -= I_MX;
        if (r < I_L1) { tr_item(a.in[7], 64, 512, (bf16*)(a.ws + WS_W2T), 64, 0, 0, 0, scr, r, lane); continue; } r -= I_L1;
        if (r < I_L1) { tr_item(a.in[9], 64, 512, (bf16*)(a.ws + WS_A2T), 64, 0, 0, 0, scr, r, lane); continue; } r -= I_L1;
        tr_item(a.in[10], 128, 512, (bf16*)(a.ws + WS_G2T), 128, 0, 0, 0, scr, r, lane);
    }
    const u4 z = {0u, 0u, 0u, 0u};
    for (int i = blockIdx.x * NT + tid; i < 240 * 128; i += gridDim.x * NT) *((u4*)(WinT + (size_t)3344 * 1024) + i) = z;
}
__device__ __forceinline__ void p1_modulate(const float* __restrict__ x, const float* __restrict__ MOD, bf16* __restrict__ U) {
    const int tid = threadIdx.x, lane = tid & 63, wave = tid >> 6;
    const int gw = blockIdx.x * NWAVE + wave, NGW = gridDim.x * NWAVE;
    for (int m = gw; m < M; m += 2 * NGW) {
        const int m2 = m + NGW;
        const bool has2 = m2 < M; const int mm2 = has2 ? m2 : m;
        const int b = m >> 11, b2 = mm2 >> 11;
        const f4* xr = (const f4*)(x + (size_t)m * D) + lane; const f4* xr2 = (const f4*)(x + (size_t)mm2 * D) + lane;
        const f4* sh = (const f4*)(MOD + b * 6144) + lane; const f4* sc = (const f4*)(MOD + b * 6144 + 1024) + lane;
        const f4* sh2 = (const f4*)(MOD + b2 * 6144) + lane; const f4* sc2 = (const f4*)(MOD + b2 * 6144 + 1024) + lane;
        f4 v[4], s[4], h[4], v2[4], s2[4], h2[4];
#pragma unroll
        for (int j = 0; j < 4; ++j) { v[j] = xr[64 * j]; v2[j] = xr2[64 * j]; s[j] = sc[64 * j]; h[j] = sh[64 * j]; s2[j] = sc2[64 * j]; h2[j] = sh2[64 * j]; }
        u2* o = (u2*)(U + (size_t)m * D) + lane; u2* o2 = (u2*)(U + (size_t)mm2 * D) + lane;
#pragma unroll
        for (int j = 0; j < 4; ++j) { const f4 r = v[j] * (s[j] + 1.0f) + h[j]; u2 w; w.x = pk2(r.x, r.y); w.y = pk2(r.z, r.w); o[64 * j] = w; }
        if (has2) {
#pragma unroll
            for (int j = 0; j < 4; ++j) { const f4 r = v2[j] * (s2[j] + 1.0f) + h2[j]; u2 w; w.x = pk2(r.x, r.y); w.y = pk2(r.z, r.w); o2[64 * j] = w; } }
    }
}
__device__ __forceinline__ void p3_lora(const Args& a, LAS unsigned char* L) {
    typedef short bf16x8 __attribute__((ext_vector_type(8)));
    const int tid = threadIdx.x, lane = tid & 63, wave = tid >> 6, fr = lane & 15, fq = lane >> 4;
    const bf16* __restrict__ RWP = (const bf16*)(a.ws + WS_RWP);
    const float* mu = a.in[5]; const float* w0 = a.in[6]; const float* a0 = a.in[8];
    float* E = a.out; bf16* A = (bf16*)(a.out + (size_t)8 * MiB); bf16* G = (bf16*)(a.out + (size_t)12 * MiB);
    float* INVN = (float*)(a.ws + WS_INVN); float* SB = (float*)(a.ws + WS_SB);
    const bf16* w2T = (const bf16*)(a.ws + WS_W2T); const bf16* a2T = (const bf16*)(a.ws + WS_A2T); const bf16* g2T = (const bf16*)(a.ws + WS_G2T);
    constexpr int PW = 72, PG = 136;
    LAS bf16* TW = (LAS bf16*)L; LAS bf16* TA = TW + 32 * PW; LAS bf16* TG = TA + 32 * PW; LAS float* AVL = (LAS float*)(TG + 32 * PG);
    float w0c[4], a0c[4];
#pragma unroll
    for (int nt = 0; nt < 4; ++nt) { w0c[nt] = w0[64 * wave + 16 * nt + fr]; a0c[nt] = a0[64 * wave + 16 * nt + fr]; }
    const int j = tid;
    const float kkw = a.in[11][j], kaw = a.in[12][j], rkw = a.in[13][j], mu_r = mu[j], mu_k = mu[512 + j];
    for (int tile = blockIdx.x; tile < M / 32; tile += gridDim.x) {
        const int m0 = tile * 32;
        __syncthreads();
        { float p[16], pp[16];
#pragma unroll
          for (int i = 0; i < 16; ++i) { const int e = tid + i * NT, tl = e >> 8, ci = e & 255, col = 1536 + ci, m = m0 + tl; const size_t mq = (m & 2047) ? (size_t)(m - 1) : (size_t)m;
            p[i] = bf2f(RWP[(size_t)m * RWC + col]); pp[i] = bf2f(RWP[mq * RWC + col]); }
#pragma unroll
          for (int i = 0; i < 16; ++i) { const int e = tid + i * NT, tl = e >> 8, ci = e & 255, col = 1536 + ci, m = m0 + tl;
            const float pq = (m & 2047) ? pp[i] : 0.f; const float ps = p[i] + mu[col] * (pq - p[i]);
            if (ci < 64) TW[tl * PW + ci] = (bf16)f2bf(tanhf(ps)); else if (ci < 128) TA[tl * PW + ci - 64] = (bf16)f2bf(ps); else TG[tl * PG + ci - 128] = (bf16)f2bf(sigm(ps)); } }
        __syncthreads();
#pragma unroll
        for (int mt = 0; mt < 2; ++mt) { const bf16x8 af0 = *(const LAS bf16x8*)(TW + (16 * mt + fr) * PW + 8 * fq), af1 = *(const LAS bf16x8*)(TW + (16 * mt + fr) * PW + 32 + 8 * fq);
#pragma unroll
            for (int nt = 0; nt < 4; ++nt) { const bf16* bp = w2T + (size_t)(64 * wave + 16 * nt + fr) * 64 + 8 * fq; const bf16x8 b0 = *(const bf16x8*)bp, b1 = *(const bf16x8*)(bp + 32);
                pg8::f32x4 acc = {0.f, 0.f, 0.f, 0.f}; acc = __builtin_amdgcn_mfma_f32_16x16x32_bf16(af0, b0, acc, 0, 0, 0); acc = __builtin_amdgcn_mfma_f32_16x16x32_bf16(af1, b1, acc, 0, 0, 0);
#pragma unroll
                for (int jj = 0; jj < 4; ++jj) E[(size_t)(m0 + 16 * mt + 4 * fq + jj) * 512 + 64 * wave + 16 * nt + fr] = 0.6065306597126334f * sigm(w0c[nt] + acc[jj]); } }
#pragma unroll
        for (int mt = 0; mt < 2; ++mt) { const bf16x8 af0 = *(const LAS bf16x8*)(TA + (16 * mt + fr) * PW + 8 * fq), af1 = *(const LAS bf16x8*)(TA + (16 * mt + fr) * PW + 32 + 8 * fq);
#pragma unroll
            for (int nt = 0; nt < 4; ++nt) { const bf16* bp = a2T + (size_t)(64 * wave + 16 * nt + fr) * 64 + 8 * fq; const bf16x8 b0 = *(const bf16x8*)bp, b1 = *(const bf16x8*)(bp + 32);
                pg8::f32x4 acc = {0.f, 0.f, 0.f, 0.f}; acc = __builtin_amdgcn_mfma_f32_16x16x32_bf16(af0, b0, acc, 0, 0, 0); acc = __builtin_amdgcn_mfma_f32_16x16x32_bf16(af1, b1, acc, 0, 0, 0);
#pragma unroll
                for (int jj = 0; jj < 4; ++jj) { const float av = sigm(a0c[nt] + acc[jj]); const int tl = 16 * mt + 4 * fq + jj, col = 64 * wave + 16 * nt + fr;
                    A[(size_t)(m0 + tl) * 512 + col] = (bf16)f2bf(av); AVL[tl * 512 + col] = av; } } }
#pragma unroll
        for (int mt = 0; mt < 2; ++mt) { bf16x8 af[4];
#pragma unroll
            for (int ks = 0; ks < 4; ++ks) af[ks] = *(const LAS bf16x8*)(TG + (16 * mt + fr) * PG + 32 * ks + 8 * fq);
#pragma unroll
            for (int nt = 0; nt < 4; ++nt) { const bf16* bp = g2T + (size_t)(64 * wave + 16 * nt + fr) * 128 + 8 * fq; pg8::f32x4 acc = {0.f, 0.f, 0.f, 0.f};
#pragma unroll
                for (int ks = 0; ks < 4; ++ks) acc = __builtin_amdgcn_mfma_f32_16x16x32_bf16(af[ks], *(const bf16x8*)(bp + 32 * ks), acc, 0, 0, 0);
#pragma unroll
                for (int jj = 0; jj < 4; ++jj) G[(size_t)(m0 + 16 * mt + 4 * fq + jj) * 512 + 64 * wave + 16 * nt + fr] = (bf16)f2bf(acc[jj]); } }
        __syncthreads();
#pragma unroll
        for (int q = 0; q < 8; ++q) {
            float rv_[5], kv_[5];
#pragma unroll
            for (int i = 0; i < 5; ++i) { const int m = m0 + 4 * q + i - 1; const bool ok = (i > 0) || ((m + 1) & 2047); const size_t mm = ok ? (size_t)m : (size_t)(m + 1);
                rv_[i] = bf2f(RWP[mm * RWC + j]); kv_[i] = bf2f(RWP[mm * RWC + 512 + j]); if (!ok) { rv_[i] = 0.f; kv_[i] = 0.f; } }
#pragma unroll
            for (int i = 0; i < 4; ++i) { const int m = m0 + 4 * q + i; const float av = AVL[(4 * q + i) * 512 + j];
                const float r = rv_[i + 1] + mu_r * (rv_[i] - rv_[i + 1]), k = kv_[i + 1] + mu_k * (kv_[i] - kv_[i + 1]);
                const float kkv = k * kkw; float n2 = reduce16(kkv * kkv); n2 += __shfl_xor(n2, 16); n2 += __shfl_xor(n2, 32);
                const float k2 = k * (1.f + (av - 1.f) * kaw); float sb = reduce16(r * k2 * rkw); sb += __shfl_xor(sb, 16); sb += __shfl_xor(sb, 32);
                if (lane == 0) { INVN[(size_t)m * 8 + wave] = 1.f / fmaxf(sqrtf(n2), 1e-12f); SB[(size_t)m * 8 + wave] = sb; } } }
    }
}
__device__ __forceinline__ void gla_pre(const Args& a, LAS float* ldsf) {
    const int tid = threadIdx.x, dd = tid & 63, tg = tid >> 6;
    bf16* GLAP = (bf16*)(a.ws + WS_GLAP); bf16* KDT = (bf16*)(a.ws + WS_KDT); float* DECG = (float*)(a.ws + WS_DECG);
    const float* ga2 = a.in[16]; const float* gab = a.in[17];
    LAS float* AD = ldsf; LAS float* GT = ldsf + 1024;
    for (int u = blockIdx.x; u < 1024; u += gridDim.x) {
        const int bh = u >> 5, c = u & 31, b = bh >> 2, h = bh & 3; const size_t m0 = (size_t)b * SEQ + (size_t)c * 64;
        float a2r[16];
#pragma unroll
        for (int j = 0; j < 16; ++j) a2r[j] = ga2[j * 256 + h * 64 + dd];
        const float abr = gab[h * 64 + dd];
        float qv[8], kv[8];
#pragma unroll
        for (int i = 0; i < 8; ++i) { const bf16* p = GLAP + (m0 + tg * 8 + i) * GLCP + h * 64 + dd; qv[i] = bf2f(p[0]); kv[i] = bf2f(p[256]); }
        __syncthreads();
#pragma unroll
        for (int i = 0; i < 2; ++i) { const int e = tid + NT * i, t = e >> 4, j = e & 15; AD[e] = bf2f(GLAP[(m0 + t) * GLCP + 1536 + j]); }
        __syncthreads();
        float bl[8]; float run = 0.f;
#pragma unroll
        for (int i = 0; i < 8; ++i) { const int t = tg * 8 + i; float z = abr;
#pragma unroll
            for (int j4 = 0; j4 < 4; ++j4) { const f4 av = *(const LAS f4*)(AD + t * 16 + 4 * j4); z += av.x * a2r[4 * j4] + av.y * a2r[4 * j4 + 1] + av.z * a2r[4 * j4 + 2] + av.w * a2r[4 * j4 + 3]; }
            const float ls = fminf(z, 0.f) - __logf(1.f + __expf(-fabsf(z)));
            run += ls * 0.0625f; bl[i] = run; }
        GT[tg * 64 + dd] = run;
        __syncthreads();
        float off = 0.f, tot = 0.f;
#pragma unroll
        for (int g = 0; g < 8; ++g) { const float gv = GT[g * 64 + dd]; off += (g < tg) ? gv : 0.f; tot += gv; }
        unsigned kd[4];
#pragma unroll
        for (int i = 0; i < 8; ++i) { const float bc = bl[i] + off; bf16* p = GLAP + (m0 + tg * 8 + i) * GLCP + h * 64 + dd;
            p[0] = (bf16)f2bf(qv[i] * 0.125f * __expf(bc)); p[256] = (bf16)f2bf(kv[i] * __expf(-bc));
            const unsigned kdb = f2bf(kv[i] * __expf(tot - bc)); if (i & 1) kd[i >> 1] |= kdb << 16; else kd[i >> 1] = kdb; }
        *(u4*)(KDT + ((size_t)u * 64 + dd) * 64 + tg * 8) = (u4){kd[0], kd[1], kd[2], kd[3]};
        if (tg == 0) DECG[u * 64 + dd] = __expf(tot);
    }
}
__device__ __forceinline__ void rw_scan_unit(const Args& a, LAS float* ldsf, int unit) {
    const int tid = threadIdx.x, lane = tid & 63, wave = tid >> 6;
    const int bh = unit >> 2, qr = unit & 3, b = bh >> 3, h = bh & 7;
    const bf16* RWP = (const bf16*)(a.ws + WS_RWP);
    const float* E = a.out; const bf16* A = (const bf16*)(a.out + (size_t)8 * MiB);
    bf16* Yraw = (bf16*)(a.ws + WS_U);
    const float* mu = a.in[5];
    const int col = h * 64 + lane;
    const float mu_r = mu[col], mu_k = mu[512 + col], mu_v = mu[1024 + col];
    const float kkw = a.in[11][col], kaw = a.in[12][col];
    constexpr int BUF = 6 * 2048, NCH = 64 * REP_RW;
    LAS float* Ybuf = ldsf + 2 * BUF;
    const int rowl = (tid >> 4) & 15, kq = tid & 15;
    const size_t mb = (size_t)b * SEQ;
    const int pw = wave & 3;
    unsigned short rrA[9], rkA[9], rvA[9], raA[8]; float reA[8], rnA[8];
    unsigned short rrB[9], rkB[9], rvB[9], raB[8]; float reB[8], rnB[8];
    const float* INVN = (const float*)(a.ws + WS_INVN);
#define RW_LOAD(c, S) do { const int t0 = (c) * 32 + 8 * pw; const bf16* p = RWP + (mb + t0) * RWC + col; const bf16* q = t0 ? p - RWC : p; rr##S[0] = q[0]; rk##S[0] = q[512]; rv##S[0] = q[1024]; \
        _Pragma("unroll") for (int i = 0; i < 8; ++i) { rr##S[i + 1] = p[(size_t)i * RWC]; rk##S[i + 1] = p[(size_t)i * RWC + 512]; rv##S[i + 1] = p[(size_t)i * RWC + 1024]; \
            re##S[i] = E[(mb + t0 + i) * 512 + col]; ra##S[i] = A[(mb + t0 + i) * 512 + col]; rn##S[i] = INVN[(mb + t0 + i) * 8 + h]; } } while (0)
#define RW_FINAL(c, buf, S) do { LAS float* B_ = ldsf + (buf) * BUF; const int t0 = (c) * 32 + 8 * pw; _Pragma("unroll") for (int i = 0; i < 8; ++i) { const int tl = 8 * pw + i; \
        const float rp = bf2f(rr##S[i + 1]), kp = bf2f(rk##S[i + 1]), vp = bf2f(rv##S[i + 1]); const bool has = (t0 + i) != 0; \
        const float rq = has ? bf2f(rr##S[i]) : 0.f, kq_ = has ? bf2f(rk##S[i]) : 0.f, vq = has ? bf2f(rv##S[i]) : 0.f; \
        const float r = rp + mu_r * (rq - rp), k = kp + mu_k * (kq_ - kp), v = vp + mu_v * (vq - vp); \
        const float av = bf2f(ra##S[i]); const float dec = __expf(-re##S[i]); \
        const float kkn = k * kkw * rn##S[i]; const float k2 = k * (1.f + (av - 1.f) * kaw); const float bb = kkn * av; \
        B_[0 * 2048 + tl * 64 + lane] = r; B_[1 * 2048 + tl * 64 + lane] = dec; B_[2 * 2048 + tl * 64 + lane] = k2; \
        B_[3 * 2048 + tl * 64 + lane] = v; B_[4 * 2048 + tl * 64 + lane] = -kkn; B_[5 * 2048 + tl * 64 + lane] = bb; } } while (0)
#define RW_YOUT(c) do { const LAS float* Y_ = Ybuf + ((c) & 1) * 512; const int e = (tid - 256) * 2, tl = e >> 4, rl = e & 15; const f2 yv = *(const LAS f2*)(Y_ + e); \
        *(unsigned*)(Yraw + (mb + (size_t)(c) * 32 + tl) * 512 + h * 64 + qr * 16 + rl) = pk2(yv.x, yv.y); } while (0)
#define RW_CONSUME(cc) RW_CONSUME_(cc, 0, sA, sB)
#define RW_OPS(P_, tl_) P_##r4 = *(const LAS f4*)(Bc + 0 * 2048 + (tl_) * 64); P_##w4 = *(const LAS f4*)(Bc + 1 * 2048 + (tl_) * 64); P_##k4 = *(const LAS f4*)(Bc + 2 * 2048 + (tl_) * 64); \
                         P_##n4 = *(const LAS f4*)(Bc + 4 * 2048 + (tl_) * 64); P_##b4 = *(const LAS f4*)(Bc + 5 * 2048 + (tl_) * 64); P_##v1 = Vc[(tl_) * 64];
#define RW_UPDATE(sa_) do { const f2 vkA = (f2){c_k4.x, c_k4.y} * c_v1, vkB = (f2){c_k4.z, c_k4.w} * c_v1; const f2 sa2 = {sa_, sa_}; \
                const f2 tA = __builtin_elementwise_fma(sa2, (f2){c_b4.x, c_b4.y}, vkA), tB = __builtin_elementwise_fma(sa2, (f2){c_b4.z, c_b4.w}, vkB); \
                sA = __builtin_elementwise_fma(sA, (f2){c_w4.x, c_w4.y}, tA); sB = __builtin_elementwise_fma(sB, (f2){c_w4.z, c_w4.w}, tB); } while (0)
#define RW_CONSUME_(cc, YOFF, sA, sB) do { \
            const LAS float* Bc = ldsf + ((cc) & 1) * BUF + 4 * kq; \
            LAS float* Yw = (kq == 0) ? (Ybuf + (YOFF) + ((cc) & 1) * 512 + rowl) : (Ybuf + 2048 + tid); const int ystr = (kq == 0) ? 16 : 0; \
            const LAS float* Vc = ldsf + ((cc) & 1) * BUF + 3 * 2048 + qr * 16 + rowl; \
            f4 rprev, c_r4, c_w4, c_k4, c_n4, c_b4, x_r4, x_w4, x_k4, x_n4, x_b4; float c_v1, x_v1; \
            RW_OPS(c_, 0) RW_OPS(x_, 1) \
            { f2 pp = sA * (f2){c_n4.x, c_n4.y}; pp = __builtin_elementwise_fma(sB, (f2){c_n4.z, c_n4.w}, pp); const float sa = reduce16(pp.x + pp.y); RW_UPDATE(sa); rprev = c_r4; } \
            _Pragma("unroll 2") for (int tl = 1; tl < 32; ++tl) { \
                c_r4 = x_r4; c_w4 = x_w4; c_k4 = x_k4; c_n4 = x_n4; c_b4 = x_b4; c_v1 = x_v1; \
                RW_OPS(x_, (tl + 1) & 31) \
                f2 pp = sA * (f2){c_n4.x, c_n4.y}; f2 yy = sA * (f2){rprev.x, rprev.y}; \
                pp = __builtin_elementwise_fma(sB, (f2){c_n4.z, c_n4.w}, pp); yy = __builtin_elementwise_fma(sB, (f2){rprev.z, rprev.w}, yy); \
                float p = pp.x + pp.y, y = yy.x + yy.y; \
                p += dppf<0xB1>(p); y += dppf<0xB1>(y); p += dppf<0x4E>(p); y += dppf<0x4E>(y); p += dppf<0x141>(p); y += dppf<0x141>(y); p += dppf<0x128>(p); y += dppf<0x128>(y); \
                Yw[(tl - 1) * ystr] = y; \
                RW_UPDATE(p); rprev = c_r4; } \
            { f2 yy = sA * (f2){rprev.x, rprev.y}; yy = __builtin_elementwise_fma(sB, (f2){rprev.z, rprev.w}, yy); const float y = reduce16(yy.x + yy.y); Yw[31 * ystr] = y; } } while (0)
#define RW_PRODUCE(cc, SL, SF) do { if ((cc) > 0) RW_YOUT(((cc) - 1) & 63); if ((cc) + 1 < NCH) { RW_LOAD(((cc) + 2) & 63, SL); RW_FINAL(((cc) + 1) & 63, ((cc) + 1) & 1, SF); } } while (0)
#ifndef REP_CONS
#define REP_CONS 1
#endif
#ifndef REP_PROD
#define REP_PROD 1
#endif
#define RW_CONS2(cc) do { if (REP_CONS > 1) { const f2 sA0 = sA, sB0 = sB; RW_CONSUME(cc); sA = sA0; sB = sB0; } RW_CONSUME(cc); } while (0)
#define RW_PROD2(cc, SF) do { if (REP_PROD > 1 && (cc) + 1 < NCH) { RW_FINAL(((cc) + 1) & 63, ((cc) + 1) & 1, SF); } } while (0)
    __syncthreads();
    if (wave >= 4) { RW_LOAD(0, A); RW_LOAD(1, B); RW_FINAL(0, 0, A); }
    __syncthreads();
#ifndef DUP_CONS
#define DUP_CONS 0
#endif
    f2 sA = {0.f, 0.f}, sB = {0.f, 0.f}; f2 dA = {0.f, 0.f}, dB = {0.f, 0.f};
    for (int cc_ = 0; cc_ < NCH; cc_ += 2) {
        if (wave < 4) { if (REP_RW > 1 && (cc_ & 63) == 0) { sA = (f2){0.f, 0.f}; sB = (f2){0.f, 0.f}; } RW_CONS2(cc_); } else { RW_PRODUCE(cc_, A, B); RW_PROD2(cc_, B); if (DUP_CONS) RW_CONSUME_(cc_, 1024, dA, dB); }
        __syncthreads();
        if (wave < 4) { RW_CONS2(cc_ + 1); } else { RW_PRODUCE(cc_ + 1, B, A); RW_PROD2(cc_ + 1, A); if (DUP_CONS) RW_CONSUME_(cc_ + 1, 1024, dA, dB); }
        __syncthreads();
    }
    if (wave >= 4) RW_YOUT((NCH - 1) & 63);
#undef RW_LOAD
#undef RW_FINAL
#undef RW_YOUT
#undef RW_CONSUME
#undef RW_CONSUME_
#undef RW_OPS
#undef RW_UPDATE
#undef RW_PRODUCE
}
__device__ __forceinline__ void gla_unit(const Args& a, LAS unsigned char* L, int unit) {
    typedef short bf16x8 __attribute__((ext_vector_type(8)));
    const int tid = threadIdx.x, lane = tid & 63, wave = tid >> 6, fr = lane & 15, fq = lane >> 4;
    const int bh = unit >> 3, vs = unit & 7, b = bh >> 2, h = bh & 3;
    const bf16* GLAP = (const bf16*)(a.ws + WS_GLAP); bf16* Oraw = (bf16*)(a.ws + WS_U + 16 * MiB);
    const bf16* KDT = (const bf16*)(a.ws + WS_KDT); const float* DECG = (const float*)(a.ws + WS_DECG);
    constexpr int P = 72;
    LAS bf16* Qs = (LAS bf16*)L; LAS bf16* Ks = Qs + 64 * P; LAS bf16* Kdt = Ks + 64 * P; LAS bf16* Att = Kdt + 64 * P;
    LAS bf16* Vt = Att + 64 * P; LAS bf16* St = Vt + 16 * P;
    LAS float* DEC = (LAS float*)(St + 2 * 16 * P);
    const size_t mb = (size_t)b * SEQ;
    constexpr int NCH = 32 * REP_GLA;
    const int lt = tid >> 3, lp = tid & 7;
    u4 pq, pk, pd, pv; float pdec;
#define GLA_LOAD(c) do { const size_t m0 = mb + (size_t)(c) * 64; const bf16* p = GLAP + (m0 + lt) * GLCP + h * 64 + lp * 8; pq = *(const u4*)p; pk = *(const u4*)(p + 256); \
        const int uc = bh * 32 + (c); pd = *(const u4*)(KDT + ((size_t)uc * 64 + lt) * 64 + lp * 8); \
        if (tid < 128) pv = *(const u4*)(GLAP + (m0 + (tid >> 1)) * GLCP + 512 + h * 128 + vs * 16 + (tid & 1) * 8); \
        if (tid < 64) pdec = DECG[uc * 64 + tid]; } while (0)
#define GLA_STORE() do { *(LAS u4*)(Qs + lt * P + lp * 8) = pq; *(LAS u4*)(Ks + lt * P + lp * 8) = pk; *(LAS u4*)(Kdt + lt * P + lp * 8) = pd; \
        if (tid < 128) { const int t = tid >> 1, v0 = (tid & 1) * 8; Vt[(v0 + 0) * P + t] = (bf16)(pv.x & 0xffffu); Vt[(v0 + 1) * P + t] = (bf16)(pv.x >> 16); Vt[(v0 + 2) * P + t] = (bf16)(pv.y & 0xffffu); Vt[(v0 + 3) * P + t] = (bf16)(pv.y >> 16); \
            Vt[(v0 + 4) * P + t] = (bf16)(pv.z & 0xffffu); Vt[(v0 + 5) * P + t] = (bf16)(pv.z >> 16); Vt[(v0 + 6) * P + t] = (bf16)(pv.w & 0xffffu); Vt[(v0 + 7) * P + t] = (bf16)(pv.w >> 16); } \
        if (tid < 64) DEC[tid] = pdec; } while (0)
    __syncthreads();
    for (int i = tid; i < 2 * 16 * P; i += NT) St[i] = 0;
    GLA_LOAD(0); GLA_STORE();
    pg8::f32x4 Sacc = {0.f, 0.f, 0.f, 0.f};
    __syncthreads();
    for (int cc_ = 0; cc_ < NCH; ++cc_) {
        const int c = cc_ & 31;
        if (REP_GLA > 1 && c == 0 && cc_ > 0) { Sacc = (pg8::f32x4){0.f, 0.f, 0.f, 0.f}; for (int i = tid; i < 2 * 16 * P; i += NT) St[i] = 0; __syncthreads(); }
        if (cc_ + 1 < NCH) GLA_LOAD((cc_ + 1) & 31);
        { const int mt = wave >> 1;
          const bf16x8 qa0 = *(const LAS bf16x8*)(Qs + (16 * mt + fr) * P + fq * 8), qa1 = *(const LAS bf16x8*)(Qs + (16 * mt + fr) * P + 32 + fq * 8);
#pragma unroll
          for (int u = 0; u < 2; ++u) { const int nt = 2 * (wave & 1) + u; pg8::f32x4 acc = {0.f, 0.f, 0.f, 0.f};
            if (nt <= mt) { const bf16x8 kb0 = *(const LAS bf16x8*)(Ks + (16 * nt + fr) * P + fq * 8), kb1 = *(const LAS bf16x8*)(Ks + (16 * nt + fr) * P + 32 + fq * 8);
                acc = __builtin_amdgcn_mfma_f32_16x16x32_bf16(qa0, kb0, acc, 0, 0, 0); acc = __builtin_amdgcn_mfma_f32_16x16x32_bf16(qa1, kb1, acc, 0, 0, 0); }
#pragma unroll
            for (int j = 0; j < 4; ++j) { const bool keep = (nt < mt) || (nt == mt && fr <= fq * 4 + j); Att[(16 * mt + fq * 4 + j) * P + 16 * nt + fr] = (bf16)f2bf(keep ? acc[j] : 0.f); } } }
        __syncthreads();
        { const LAS bf16* Sc = St + (cc_ & 1) * 16 * P; LAS bf16* Sn = St + ((cc_ + 1) & 1) * 16 * P;
          const bf16x8 vb0 = *(const LAS bf16x8*)(Vt + fr * P + fq * 8), vb1 = *(const LAS bf16x8*)(Vt + fr * P + 32 + fq * 8);
          if (wave < 4) { const int mt = wave; pg8::f32x4 acc = {0.f, 0.f, 0.f, 0.f};
            const bf16x8 aa0 = *(const LAS bf16x8*)(Att + (16 * mt + fr) * P + fq * 8), aa1 = *(const LAS bf16x8*)(Att + (16 * mt + fr) * P + 32 + fq * 8);
            const bf16x8 qa0 = *(const LAS bf16x8*)(Qs + (16 * mt + fr) * P + fq * 8), qa1 = *(const LAS bf16x8*)(Qs + (16 * mt + fr) * P + 32 + fq * 8);
            const bf16x8 sb0 = *(const LAS bf16x8*)(Sc + fr * P + fq * 8), sb1 = *(const LAS bf16x8*)(Sc + fr * P + 32 + fq * 8);
            acc = __builtin_amdgcn_mfma_f32_16x16x32_bf16(aa0, vb0, acc, 0, 0, 0); acc = __builtin_amdgcn_mfma_f32_16x16x32_bf16(aa1, vb1, acc, 0, 0, 0);
            acc = __builtin_amdgcn_mfma_f32_16x16x32_bf16(qa0, sb0, acc, 0, 0, 0); acc = __builtin_amdgcn_mfma_f32_16x16x32_bf16(qa1, sb1, acc, 0, 0, 0);
#pragma unroll
            for (int j = 0; j < 4; ++j) Oraw[(mb + (size_t)c * 64 + 16 * mt + fq * 4 + j) * 512 + h * 128 + vs * 16 + fr] = (bf16)f2bf(acc[j]);
          } else { const int dt = wave - 4;
            const bf16x8 ka0 = *(const LAS bf16x8*)(Kdt + (16 * dt + fr) * P + fq * 8), ka1 = *(const LAS bf16x8*)(Kdt + (16 * dt + fr) * P + 32 + fq * 8);
            const f4 dc = *(const LAS f4*)(DEC + 16 * dt + fq * 4);
            Sacc[0] *= dc.x; Sacc[1] *= dc.y; Sacc[2] *= dc.z; Sacc[3] *= dc.w;
            Sacc = __builtin_amdgcn_mfma_f32_16x16x32_bf16(ka0, vb0, Sacc, 0, 0, 0); Sacc = __builtin_amdgcn_mfma_f32_16x16x32_bf16(ka1, vb1, Sacc, 0, 0, 0);
            *(LAS u2*)(Sn + fr * P + 16 * dt + fq * 4) = (u2){pk2(Sacc[0], Sacc[1]), pk2(Sacc[2], Sacc[3])}; } }
        __syncthreads();
        if (cc_ + 1 < NCH) GLA_STORE();
        __syncthreads();
    }
#undef GLA_LOAD
#undef GLA_STORE
}
__device__ __forceinline__ void p5_post(const Args& a) {
    const int tid = threadIdx.x, lane = tid & 63, wave = tid >> 6;
    const int gw = blockIdx.x * NWAVE + wave, NGW = gridDim.x * NWAVE;
    const bf16* __restrict__ RWP = (const bf16*)(a.ws + WS_RWP); const bf16* __restrict__ GLAP = (const bf16*)(a.ws + WS_GLAP);
    bf16* Yraw = (bf16*)(a.ws + WS_U); bf16* Oraw = (bf16*)(a.ws + WS_U + 16 * MiB);
    const bf16* __restrict__ G = (const bf16*)(a.out + (size_t)12 * MiB); const float* __restrict__ SB = (const float*)(a.ws + WS_SB);
    const float* mu = a.in[5]; const float* gng = a.in[14]; const float* gnb = a.in[15]; const float* nrm = a.in[18];
    const float ng0 = nrm[lane], ng1 = nrm[64 + lane];
    for (int m = gw; m < M; m += NGW) {
        const int t = m & 2047; const size_t mq = t ? (size_t)(m - 1) : (size_t)m;
        float y[8], vp[8], vq[8], g[8], sb[8], o0[4], o1[4], g0[4], g1[4];
#pragma unroll
        for (int h = 0; h < 8; ++h) { const int col = h * 64 + lane; y[h] = bf2f(Yraw[(size_t)m * 512 + col]); vp[h] = bf2f(RWP[(size_t)m * RWC + 1024 + col]); vq[h] = bf2f(RWP[mq * RWC + 1024 + col]);
            g[h] = bf2f(G[(size_t)m * 512 + col]); sb[h] = SB[(size_t)m * 8 + h]; }
#pragma unroll
        for (int h = 0; h < 4; ++h) { const int c0 = h * 128 + lane, c1 = c0 + 64; o0[h] = bf2f(Oraw[(size_t)m * 512 + c0]); o1[h] = bf2f(Oraw[(size_t)m * 512 + c1]);
            g0[h] = bf2f(GLAP[(size_t)m * GLCP + 1024 + c0]); g1[h] = bf2f(GLAP[(size_t)m * GLCP + 1024 + c1]); }
#pragma unroll
        for (int h = 0; h < 8; ++h) { const int col = h * 64 + lane;
            const float v = vp[h] + mu[1024 + col] * ((t ? vq[h] : 0.f) - vp[h]);
            float sm = reduce16(y[h]); sm += __shfl_xor(sm, 16); sm += __shfl_xor(sm, 32);
            const float mean = sm * (1.f / 64.f); const float dl = y[h] - mean; float sv = reduce16(dl * dl); sv += __shfl_xor(sv, 16); sv += __shfl_xor(sv, 32);
            const float yn = dl * rsqrtf(sv * (1.f / 64.f) + GN_EPS) * gng[col] + gnb[col];
            Yraw[(size_t)m * 512 + col] = (bf16)f2bf((yn + sb[h] * v) * g[h]); }
#pragma unroll
        for (int h = 0; h < 4; ++h) { const int c0 = h * 128 + lane, c1 = c0 + 64;
            float ms = reduce16(o0[h] * o0[h] + o1[h] * o1[h]); ms += __shfl_xor(ms, 16); ms += __shfl_xor(ms, 32);
            const float rs = rsqrtf(ms * (1.f / 128.f) + GLA_EPS);
            Oraw[(size_t)m * 512 + c0] = (bf16)f2bf(o0[h] * rs * ng0 * g0[h] * sigm(g0[h])); Oraw[(size_t)m * 512 + c1] = (bf16)f2bf(o1[h] * rs * ng1 * g1[h] * sigm(g1[h])); }
    }
}
__device__ __forceinline__ void ln_rows(float* X, const float* __restrict__ g, const float* __restrict__ bta, const float* __restrict__ MOD, bf16* __restrict__ U2) {
    const int tid = threadIdx.x, lane = tid & 63, wave = tid >> 6;
    const int gw = blockIdx.x * NWAVE + wave, NGW = gridDim.x * NWAVE;
    f4 gg[4], bb[4];
#pragma unroll
    for (int j = 0; j < 4; ++j) { gg[j] = ((const f4*)g)[lane + 64 * j]; bb[j] = ((const f4*)bta)[lane + 64 * j]; }
    for (int m = gw; m < M; m += NGW) {
        f4* xr = (f4*)(X + (size_t)m * D) + lane; f4 v[4], sh[4], sc[4]; float s = 0.f;
        const int b = m >> 11;
#pragma unroll
        for (int j = 0; j < 4; ++j) { v[j] = xr[64 * j]; s += (v[j].x + v[j].y) + (v[j].z + v[j].w); }
        if (U2) {
#pragma unroll
            for (int j = 0; j < 4; ++j) { sh[j] = ((const f4*)(MOD + b * 6144 + 3072))[lane + 64 * j]; sc[j] = ((const f4*)(MOD + b * 6144 + 4096))[lane + 64 * j]; } }
        float sm = reduce16(s); sm += __shfl_xor(sm, 16); sm += __shfl_xor(sm, 32);
        const float mean = sm * (1.f / D); float s2 = 0.f;
#pragma unroll
        for (int j = 0; j < 4; ++j) { v[j] = v[j] - mean; s2 += (v[j].x * v[j].x + v[j].y * v[j].y) + (v[j].z * v[j].z + v[j].w * v[j].w); }
        float sq = reduce16(s2); sq += __shfl_xor(sq, 16); sq += __shfl_xor(sq, 32);
        const float rstd = rsqrtf(sq * (1.f / D) + LN_EPS);
#pragma unroll
        for (int j = 0; j < 4; ++j) { const f4 r = v[j] * rstd * gg[j] + bb[j]; xr[64 * j] = r;
            if (U2) { const f4 uu = r * (sc[j] + 1.0f) + sh[j]; u2 w; w.x = pk2(uu.x, uu.y); w.y = pk2(uu.z, uu.w); ((u2*)(U2 + (size_t)m * D))[lane + 64 * j] = w; } }
    }
}

#ifndef REPMASK
#define REPMASK 0
#endif
#define PH_BEGIN(k) _Pragma("unroll") for (int rep_ = 0; rep_ < 1 + ((REPMASK >> (k)) & 1); ++rep_) {
#define PH_END() xcd_barrier(xbar); }
#define PH_END_CG() grid.sync(); }
__global__ void __launch_bounds__(NT, 2) fwd_mega(Args a) {
    extern __shared__ __attribute__((aligned(16))) unsigned char lds[];
    cg::grid_group grid = cg::this_grid();
    LAS unsigned char* L = (LAS unsigned char*)lds; LAS float* ldsf = (LAS float*)lds;
    unsigned char* ws = a.ws;
    float* MOD = (float*)(ws + WS_MOD);
    bf16* U = (bf16*)(ws + WS_U);
    const int G = gridDim.x;
    volatile LAS unsigned* xst = (volatile LAS unsigned*)(L + LDS_BYTES - 16);
    if (threadIdx.x < 4) xst[threadIdx.x] = 0u;
    __syncthreads();
    XcdBarrier xbar = xcd_barrier_post((unsigned*)(ws + WS_BAR), xst);
    PH_BEGIN(0)
    p0_mod(a.in[1], a.in[2], a.in[3], MOD, ldsf);
    p0_weights(a, ldsf);
    PH_END_CG()
    PH_BEGIN(1)
    p1_modulate(a.in[0], MOD, U);
    PH_END()
    PH_BEGIN(2)
    { pg8::Gemm g{U, (const bf16*)(ws + WS_WIN), M, NPROJ, D, U, 0}; pg8::StaticOrder S; S.init(M, NPROJ, G, (int)blockIdx.x);
      EpiProj E{(bf16*)(ws + WS_RWP), (bf16*)(ws + WS_GLAP), (bf16*)(ws + WS_GATES)};
      pg8::gemm_phase<EpiProj, pg8::StaticOrder, true, true>(L, g, S, E); }
    PH_END()
    PH_BEGIN(3)
    p3_lora(a, L);
    gla_pre(a, ldsf);
    PH_END()
    PH_BEGIN(4)
    for (int unit = blockIdx.x; unit < 256; unit += G) rw_scan_unit(a, ldsf, unit);
    __syncthreads();
    for (int unit = blockIdx.x; unit < 256; unit += G) gla_unit(a, L, unit);
    PH_END()
    PH_BEGIN(5)
    p5_post(a);
    PH_END()
    PH_BEGIN(6)
    { pg8::Gemm g{U, (const bf16*)(ws + WS_WBR), M, D, 512, (const bf16*)(ws + WS_U + 16 * MiB), 4}; pg8::TwoPartOrder S; S.init(M, D, G, (int)blockIdx.x);
      EpiGate E{(bf16*)(ws + WS_MG), (const bf16*)(ws + WS_GATES)};
      pg8::gemm_phase<EpiGate, pg8::TwoPartOrder, true, true>(L, g, S, E); }
    PH_END()
    PH_BEGIN(7)
    { pg8::Gemm g{(const bf16*)(ws + WS_MG), (const bf16*)(ws + WS_WMIX), M, D, D, (const bf16*)(ws + WS_MG), 0}; pg8::StaticOrder S; S.init(M, D, G, (int)blockIdx.x);
      EpiRes E{a.in[0], a.out, MOD + 2048};
      pg8::gemm_phase<EpiRes, pg8::StaticOrder, true, true>(L, g, S, E); }
    PH_END()
    PH_BEGIN(8)
    ln_rows(a.out, a.in[22], a.in[23], MOD, U);
    PH_END()
    PH_BEGIN(9)
    { pg8::Gemm g{U, (const bf16*)(ws + WS_W1), M, 2 * DFF, D, U, 0}; pg8::StaticOrder S; S.init(M, 2 * DFF, G, (int)blockIdx.x);
      EpiSwiGLU E{(bf16*)(ws + WS_H)};
      pg8::gemm_phase<EpiSwiGLU, pg8::StaticOrder, true, true>(L, g, S, E); }
    PH_END()
    PH_BEGIN(10)
    { pg8::Gemm g{(const bf16*)(ws + WS_H), (const bf16*)(ws + WS_W2), M, D, DFF, (const bf16*)(ws + WS_H), 0}; pg8::StaticOrder S; S.init(M, D, G, (int)blockIdx.x);
      EpiRes E{a.out, a.out, MOD + 5120};
      pg8::gemm_phase<EpiRes, pg8::StaticOrder, true, true>(L, g, S, E); }
    PH_END()
#ifdef PROBE_SYNC
    for (int q_ = 0; q_ < 10; ++q_) xcd_barrier(xbar);
#endif
#ifdef PROBE_LN
    ln_rows((float*)(ws + WS_GATES), a.in[22], a.in[23], MOD, (bf16*)(ws + WS_H));
    xcd_barrier(xbar);
#endif
    PH_BEGIN(11)
    ln_rows(a.out, a.in[26], a.in[27], MOD, nullptr);
    }
}

extern "C" void kernel_launch(void* const* d_in, const int* in_sizes, int n_in, void* d_out, int out_size, void* d_ws, size_t ws_size, hipStream_t stream) {
    static int grid = 0;
    if (grid == 0) {
        int dev = 0, cus = 0, per_cu = 0;
        hipGetDevice(&dev);
        hipDeviceGetAttribute(&cus, hipDeviceAttributeMultiprocessorCount, dev);
        if (hipFuncSetAttribute((const void*)fwd_mega, hipFuncAttributeMaxDynamicSharedMemorySize, LDS_BYTES) != hipSuccess) fprintf(stderr, "hipFuncSetAttribute failed\n");
        if (hipOccupancyMaxActiveBlocksPerMultiprocessor(&per_cu, (const void*)fwd_mega, NT, LDS_BYTES) != hipSuccess || per_cu < 1) { fprintf(stderr, "occupancy query: %d\n", per_cu); per_cu = 1; }
        (void)hipGetLastError();
        grid = cus * 1;
        if (grid <= 0) grid = 256;
    }
    Args a{};
    for (int i = 0; i < 28; ++i) a.in[i] = (const float*)d_in[i];
    a.out = (float*)d_out; a.ws = (unsigned char*)d_ws;
    (void)hipMemsetAsync((unsigned char*)d_ws + WS_BAR, 0, 16384, stream);
    void* args[] = {&a};
    hipError_t e = hipLaunchCooperativeKernel((const void*)fwd_mega, dim3(grid), dim3(NT), args, LDS_BYTES, stream);
    if (e != hipSuccess) fprintf(stderr, "cooperative launch failed: %s (grid %d)\n", hipGetErrorString(e), grid);
}
```
